# Optimizing an MI355X kernel written in HIP

```python
import jax
import jax.numpy as jnp
from jax import lax
import numpy as np

D_MODEL = 2048
BATCH = 2
SEQ = 4096
DEPTH = 1

GRID_W = 64
HEAD_DIM = 128
N_Q_HEADS = 8
N_KV_HEADS = 2
Q_PER_KV = N_Q_HEADS // N_KV_HEADS
ATTN_WIDTH = N_Q_HEADS * HEAD_DIM
KV_WIDTH = N_KV_HEADS * HEAD_DIM
Q_BLOCK = 128
ROPE_THETA = 10000.0
POOL_WINDOWS = (2, 4, 8, 16)
N_POOL_GROUPS = len(POOL_WINDOWS)
POOL_WIDTH = D_MODEL // 2
POOL_GROUP = POOL_WIDTH // N_POOL_GROUPS
N_BRANCHES = 2
Q_END = ATTN_WIDTH
K_END = Q_END + KV_WIDTH
V_END = K_END + KV_WIDTH
P_END = V_END + POOL_WIDTH
GA_END = P_END + D_MODEL
IN_WIDTH = GA_END + D_MODEL
MEM_LEN = 256
N_MEM_HEADS = 4
MEM_HEAD_DIM = 128
MEM_WIDTH = N_MEM_HEADS * MEM_HEAD_DIM
N_EXPERTS = 32
TOP_K = 4
D_EXPERT = D_MODEL
SWIGLU_LIMIT = 7.0
SWIGLU_ALPHA = 1.702
MOE_BLOCK = 128
NORM_EPS = 1e-6

kernel_name = "hybrid_gated_gqa_pool_moe_encoder"


def rms_norm(x, g):
    xf = x.astype(jnp.float32)
    y = xf * lax.rsqrt(jnp.mean(xf * xf, axis=-1, keepdims=True) + NORM_EPS)
    return (y * g.astype(jnp.float32)).astype(x.dtype)


def axial_rope_angles(n_tok):
    n_rows = n_tok // GRID_W
    rows = jnp.repeat(jnp.arange(n_rows, dtype=jnp.float32), GRID_W)
    cols = jnp.tile(jnp.arange(GRID_W, dtype=jnp.float32), n_rows)
    axis_dim = HEAD_DIM // 2
    inv_freq = ROPE_THETA ** (-jnp.arange(0, axis_dim, 2, dtype=jnp.float32) / axis_dim)
    return rows[:, None] * inv_freq, cols[:, None] * inv_freq


def _rotate_half(x, ang):
    half = x.shape[-1] // 2
    c, s = jnp.cos(ang), jnp.sin(ang)
    x1, x2 = x[..., :half], x[..., half:]
    return jnp.concatenate([x1 * c - x2 * s, x2 * c + x1 * s], axis=-1)


def apply_axial_rope(x, ang_row, ang_col):
    a = HEAD_DIM // 2
    xf = x.astype(jnp.float32)
    y = jnp.concatenate([_rotate_half(xf[..., :a], ang_row), _rotate_half(xf[..., a:], ang_col)], axis=-1)
    return y.astype(x.dtype)


def gqa_axial_attention(q, k, v, q_g, k_g, ang_row, ang_col):
    B, S = q.shape[0], q.shape[1]
    q = rms_norm(q, q_g).transpose(0, 2, 1, 3)
    k = rms_norm(k, k_g).transpose(0, 2, 1, 3)
    v = v.transpose(0, 2, 1, 3)
    q = apply_axial_rope(q, ang_row, ang_col)
    k = apply_axial_rope(k, ang_row, ang_col)
    q = q.reshape(B, N_KV_HEADS, Q_PER_KV, S, HEAD_DIM) * (HEAD_DIM ** -0.5)
    n_blk = S // Q_BLOCK
    qb = q.reshape(B, N_KV_HEADS, Q_PER_KV, n_blk, Q_BLOCK, HEAD_DIM).transpose(3, 0, 1, 2, 4, 5)

    def block(qi):
        s = jnp.einsum('bkgqd,bksd->bkgqs', qi, k).astype(jnp.float32)
        p = jax.nn.softmax(s, axis=-1).astype(v.dtype)
        return jnp.einsum('bkgqs,bksd->bkgqd', p, v)

    o = lax.map(block, qb)
    return o.transpose(1, 0, 4, 2, 3, 5).reshape(B, S, ATTN_WIDTH)


def multiscale_pool(u, pool_w, pool_scale):
    B, S, C = u.shape
    uf = u.astype(jnp.float32)
    cs = jnp.concatenate([jnp.zeros((B, 1, C), jnp.float32), jnp.cumsum(uf, axis=1)], axis=1)
    t = jnp.arange(S)
    outs = []
    for gi, w in enumerate(POOL_WINDOWS):
        lo = jnp.clip(t - w // 2, 0, S)
        hi = jnp.clip(t + w - w // 2, 0, S)
        csg = cs[:, :, gi * POOL_GROUP:(gi + 1) * POOL_GROUP]
        mean = (csg[:, hi] - csg[:, lo]) / (hi - lo).astype(jnp.float32)[None, :, None]
        outs.append(mean - uf[:, :, gi * POOL_GROUP:(gi + 1) * POOL_GROUP])
    p = jnp.stack(outs, axis=2)
    y = jnp.einsum('bsgc,gcd->bsgd', p, pool_w.astype(jnp.float32)).reshape(B, S, C)
    return (y * pool_scale.astype(jnp.float32)).astype(u.dtype)


def memory_cross_attention(h, m, w_cq, w_ck, w_cv, w_co):
    B, S, _ = h.shape
    M = m.shape[1]
    q = (h @ w_cq).reshape(B, S, N_MEM_HEADS, MEM_HEAD_DIM)
    k = (m @ w_ck).reshape(B, M, N_MEM_HEADS, MEM_HEAD_DIM)
    v = (m @ w_cv).reshape(B, M, N_MEM_HEADS, MEM_HEAD_DIM)
    s = jnp.einsum('bshd,bmhd->bhsm', q, k).astype(jnp.float32) * (MEM_HEAD_DIM ** -0.5)
    p = jax.nn.softmax(s, axis=-1).astype(v.dtype)
    o = jnp.einsum('bhsm,bmhd->bshd', p, v).reshape(B, S, MEM_WIDTH)
    return o @ w_co


def clamped_swiglu(hgu):
    x_glu = jnp.minimum(hgu[..., ::2], SWIGLU_LIMIT)
    x_lin = jnp.clip(hgu[..., 1::2], -SWIGLU_LIMIT, SWIGLU_LIMIT)
    return x_glu * jax.nn.sigmoid(SWIGLU_ALPHA * x_glu) * (x_lin + 1.0)


def moe(h, w_router, b_router, w_gate_up, b_gate_up, w_down, b_down):
    B, S, D = h.shape
    N = B * S
    A = N * TOP_K
    t = h.reshape(N, D)
    logits = (t @ w_router + b_router).astype(jnp.float32)
    top_val, top_idx = lax.top_k(logits, TOP_K)
    gate = jax.nn.softmax(top_val, axis=-1)
    e_flat = top_idx.reshape(A)
    tok_flat = jnp.repeat(jnp.arange(N, dtype=jnp.int32), TOP_K)
    g_flat = gate.reshape(A)
    order = jnp.argsort(e_flat)
    e_s, tok_s, g_s = e_flat[order], tok_flat[order], g_flat[order]
    counts = jnp.bincount(e_flat, length=N_EXPERTS)
    padded = (counts + MOE_BLOCK - 1) // MOE_BLOCK * MOE_BLOCK
    start = jnp.cumsum(counts) - counts
    pad_end = jnp.cumsum(padded)
    pad_start = pad_end - padded
    slot = pad_start[e_s] + (jnp.arange(A) - start[e_s])
    P = A + N_EXPERTS * MOE_BLOCK
    n_blk = P // MOE_BLOCK
    slot_tok = jnp.full((P,), N, dtype=jnp.int32).at[slot].set(tok_s)
    slot_gate = jnp.zeros((P,), jnp.float32).at[slot].set(g_s)
    blk_expert = jnp.minimum(
        jnp.searchsorted(pad_end, jnp.arange(n_blk) * MOE_BLOCK, side='right'), N_EXPERTS - 1)
    t_pad = jnp.concatenate([t, jnp.zeros((1, D), t.dtype)], axis=0)
    xs = t_pad[slot_tok].reshape(n_blk, MOE_BLOCK, D)

    def expert_block(args):
        xb, e = args
        hgu = xb @ w_gate_up[e] + b_gate_up[e]
        return clamped_swiglu(hgu) @ w_down[e] + b_down[e]

    ys = lax.map(expert_block, (xs, blk_expert)).reshape(P, D)
    ys = ys * slot_gate[:, None].astype(ys.dtype)
    out = jax.ops.segment_sum(ys, slot_tok, num_segments=N + 1)[:N]
    return out.reshape(B, S, D)


def setup_inputs(seed: int = 0) -> dict:
    key = jax.random.key(seed)
    ks = jax.random.split(key, 25)

    def nrm(k, shape, scale):
        return jax.random.normal(k, shape, jnp.float32) * scale

    def gain(k, shape):
        return 1.0 + 0.02 * jax.random.normal(k, shape, jnp.float32)

    L, D = DEPTH, D_MODEL
    return {
        "x": nrm(ks[0], (BATCH, SEQ, D), 1.0),
        "mem": nrm(ks[1], (BATCH, MEM_LEN, D), 1.0),
        "mix_norm_g": gain(ks[2], (L, D)),
        "w_in": nrm(ks[3], (L, D, IN_WIDTH), D ** -0.5),
        "q_norm_g": gain(ks[4], (L, HEAD_DIM)),
        "k_norm_g": gain(ks[5], (L, HEAD_DIM)),
        "pool_w": nrm(ks[6], (L, N_POOL_GROUPS, POOL_GROUP, POOL_GROUP), POOL_GROUP ** -0.5),
        "pool_scale": gain(ks[7], (L, POOL_WIDTH)),
        "w_attn_up": nrm(ks[8], (L, ATTN_WIDTH, D), ATTN_WIDTH ** -0.5),
        "w_pool_up": nrm(ks[9], (L, POOL_WIDTH, D), POOL_WIDTH ** -0.5),
        "w_mix_out": nrm(ks[10], (L, D, D), D ** -0.5),
        "cross_norm_g": gain(ks[11], (L, D)),
        "mem_norm_g": gain(ks[12], (L, D)),
        "w_cq": nrm(ks[13], (L, D, MEM_WIDTH), D ** -0.5),
        "w_ck": nrm(ks[14], (L, D, MEM_WIDTH), D ** -0.5),
        "w_cv": nrm(ks[15], (L, D, MEM_WIDTH), D ** -0.5),
        "w_co": nrm(ks[16], (L, MEM_WIDTH, D), MEM_WIDTH ** -0.5),
        "moe_norm_g": gain(ks[17], (L, D)),
        "w_router": nrm(ks[18], (L, D, N_EXPERTS), D ** -0.5),
        "b_router": nrm(ks[19], (L, N_EXPERTS), 0.01),
        "w_gate_up": nrm(ks[20], (L, N_EXPERTS, D, 2 * D_EXPERT), D ** -0.5),
        "b_gate_up": nrm(ks[21], (L, N_EXPERTS, 2 * D_EXPERT), 0.01),
        "w_down": nrm(ks[22], (L, N_EXPERTS, D_EXPERT, D), D_EXPERT ** -0.5),
        "b_down": nrm(ks[23], (L, N_EXPERTS, D), 0.01),
        "final_norm_g": gain(ks[24], (D,)),
    }


def reference(x, mem, mix_norm_g, w_in, q_norm_g, k_norm_g, pool_w, pool_scale, w_attn_up,
              w_pool_up, w_mix_out, cross_norm_g, mem_norm_g, w_cq, w_ck, w_cv, w_co,
              moe_norm_g, w_router, b_router, w_gate_up, b_gate_up, w_down, b_down, final_norm_g):
    B, S, _ = x.shape
    ang_row, ang_col = axial_rope_angles(S)
    for l in range(DEPTH):
        h = rms_norm(x, mix_norm_g[l])
        proj = h @ w_in[l]
        q = proj[..., :Q_END].reshape(B, S, N_Q_HEADS, HEAD_DIM)
        k = proj[..., Q_END:K_END].reshape(B, S, N_KV_HEADS, HEAD_DIM)
        v = proj[..., K_END:V_END].reshape(B, S, N_KV_HEADS, HEAD_DIM)
        u = proj[..., V_END:P_END]
        gate_attn = jax.nn.sigmoid(proj[..., P_END:GA_END])
        gate_pool = jax.nn.sigmoid(proj[..., GA_END:])
        attn = gqa_axial_attention(q, k, v, q_norm_g[l], k_norm_g[l], ang_row, ang_col)
        pool = multiscale_pool(u, pool_w[l], pool_scale[l])
        mixed = gate_attn * (attn @ w_attn_up[l]) + gate_pool * (pool @ w_pool_up[l])
        x = x + mixed @ w_mix_out[l]
        h = rms_norm(x, cross_norm_g[l])
        m = rms_norm(mem, mem_norm_g[l])
        x = x + memory_cross_attention(h, m, w_cq[l], w_ck[l], w_cv[l], w_co[l])
        h = rms_norm(x, moe_norm_g[l])
        x = x + moe(h, w_router[l], b_router[l], w_gate_up[l], b_gate_up[l], w_down[l], b_down[l])
    return rms_norm(x, final_norm_g)
```

```cpp
#include <hip/hip_runtime.h>
#include <hip/hip_bf16.h>
#include <cstdio>
#include <cstdint>
#include <cstring>

#define LAS __attribute__((address_space(3)))
#define GAS __attribute__((address_space(1)))
typedef unsigned short bf16_t;
typedef short bf16x8 __attribute__((ext_vector_type(8)));
typedef short s16x4 __attribute__((ext_vector_type(4)));
typedef float f32x4 __attribute__((ext_vector_type(4)));
typedef float f32x2 __attribute__((ext_vector_type(2)));
typedef float f32x16 __attribute__((ext_vector_type(16)));
typedef unsigned u32x4 __attribute__((ext_vector_type(4)));
typedef unsigned u32x2 __attribute__((ext_vector_type(2)));
typedef int v4i32 __attribute__((ext_vector_type(4)));
typedef int v8i32 __attribute__((ext_vector_type(8)));
#define MX_SCALE_A 0x7c7c7c7c
#define MX_SCALE_W 0x7c7c7c7c
constexpr float W_FP8_MUL = 64.f;
__device__ __forceinline__ unsigned pack4_fp8(float a, float b, float c, float d) { int r = __builtin_amdgcn_cvt_pk_fp8_f32(a, b, 0, false); r = __builtin_amdgcn_cvt_pk_fp8_f32(c, d, r, true); return (unsigned)r; }

constexpr int D_MODEL = 2048, BATCH = 2, SEQ = 4096, NTOK = BATCH * SEQ;
constexpr int Q_END = 1024, K_END = 1280, V_END = 1536, P_END = 2560, GA_END = 4608, IN_WIDTH = 6656;
constexpr int ATTN_WIDTH = 1024, POOL_WIDTH = 1024, POOL_GROUP = 256;
constexpr int MEM_LEN = 256, MEM_ROWS = BATCH * MEM_LEN, MEM_WIDTH = 512;
constexpr int N_EXPERTS = 32, TOP_K = 4, D_EXPERT = 2048;
constexpr int ECAP = NTOK;
constexpr int MAX_TILES = 160;
constexpr int SLOT_ROWS = MAX_TILES * 256;
constexpr float NORM_EPS = 1e-6f;
constexpr int F8_PITCH = 2048 + 128;

__device__ __forceinline__ unsigned cvt_pk_bf16(float lo, float hi) { unsigned r; asm volatile("v_cvt_pk_bf16_f32 %0, %1, %2" : "=v"(r) : "v"(lo), "v"(hi)); return r; }
__device__ __forceinline__ float bf_lo(unsigned u) { return __uint_as_float(u << 16); }
__device__ __forceinline__ float bf_hi(unsigned u) { return __uint_as_float(u & 0xffff0000u); }
__device__ __forceinline__ float bf1(bf16_t u) { return __uint_as_float(((unsigned)u) << 16); }
__device__ __forceinline__ float sigmoidf_(float x) { return __builtin_amdgcn_rcpf(1.f + __expf(-x)); }

namespace pg8 {
constexpr int BM = 256, BK = 64, HALF = 128, HTB = HALF * BK * 2, STAGE_BYTES = 8 * HTB, NXCD = 8, WGM = 8;
__host__ __device__ __forceinline__ int lds_byte(int r, int c) { const int st = (r >> 4) * 2 + (c >> 5), rr = r & 15, cc = c & 31, ob = rr * 64 + cc * 2; return st * 1024 + (ob ^ (((ob >> 9) & 1) << 5)); }
__host__ __device__ __forceinline__ void stage_rc(int b, int& R, int& C) { const int st = b / 1024, sb = b % 1024, swz = sb ^ (((sb >> 9) & 1) << 5); R = (st >> 1) * 16 + swz / 64; C = (st & 1) * 32 + (swz % 64) / 2; }
__host__ __device__ __forceinline__ int perm32(int rho) { const int n = rho >> 4, i = rho & 15; return 8 * (i >> 2) + 4 * n + (i & 3); }

struct Unit { int pm, pn, e, aux; };
__device__ __forceinline__ void tile_order(int L, int nM, int nN, int& pm, int& pn) {
    const int nwg = nM * nN; int wgid = L; { const int q = nwg / NXCD, r = nwg % NXCD, xcd = wgid % NXCD, off = wgid / NXCD; wgid = (xcd < r ? xcd * (q + 1) : r * (q + 1) + (xcd - r) * q) + off; }
    const int nig = WGM * nN, gid = wgid / nig, fm = gid * WGM, gsz = (nM - fm) < WGM ? (nM - fm) : WGM;
    pm = fm + ((wgid % nig) % gsz); pn = (wgid % nig) / gsz;
}

template <class Epi, class Sched, bool ALIGN_EPI, bool SP2, bool FP8 = false, int PROBE = 0>
__device__ __forceinline__ void gemm_phase(LAS unsigned char* lds, const int lda, const int ldb, const int K, const Sched& S, const Epi& E, const size_t kstepB = 128) {
    const int tid = threadIdx.x, wid = __builtin_amdgcn_readfirstlane(tid >> 6), lane = tid & 63, wr = wid >> 2, wc = wid & 3, fr = lane & 15, fq = lane >> 4;
    const int nt = K / BK;
    int sR[2], sC[2];
    unsigned voffB[2], vAc[2][2], vAn[2][2];
#pragma unroll
    for (int i = 0; i < 2; ++i) { stage_rc(tid * 16 + i * 8192, sR[i], sC[i]); const int Rb = Epi::PERM ? ((sR[i] & ~31) + perm32(sR[i] & 31)) : sR[i];
        voffB[i] = (unsigned)(Rb * ldb + sC[i]) * 2u;
        vAc[0][i] = (unsigned)(sR[i] * lda + sC[i]) * 2u; vAc[1][i] = (unsigned)((sR[i] + HALF) * lda + sC[i]) * 2u; }
    const size_t kstep = (size_t)(BK * 2);
    const size_t hstepB = (size_t)HALF * ldb * 2;
    const unsigned ldsw = (unsigned)wid * 1024u;
    const int aoff = lds_byte(wr * 64 + fr, fq * 8), boff = lds_byte(wc * 32 + fr, fq * 8);
#define PG8_SA(b, h) (((b) * 2 + (h)) * HTB)
#define PG8_SB(b, h) ((4 + (b) * 2 + (h)) * HTB)
#define PG8_STAGE(bufoff, gbase, voff) do { if constexpr (PROBE != 2) _Pragma("unroll") for (int _i = 0; _i < 2; ++_i) \
        __builtin_amdgcn_global_load_lds((const unsigned*)((const char*)(gbase) + (voff)[_i]), (LAS unsigned*)(lds + (bufoff) + ldsw + _i * 8192), 16, 0, 0); } while (0)
#define PG8_LDA(dst, b, h) do { if constexpr (FP8) { _Pragma("unroll") for (int m = 0; m < 4; ++m) { const v4i32 _lo = *(const LAS v4i32*)(lds + PG8_SA(b, h) + aoff + m * 2048), _hi = *(const LAS v4i32*)(lds + PG8_SA(b, h) + aoff + m * 2048 + 1024); \
            dst##8[m] = __builtin_shufflevector(_lo, _hi, 0, 1, 2, 3, 4, 5, 6, 7); } } \
        else { _Pragma("unroll") for (int m = 0; m < 4; ++m) _Pragma("unroll") for (int k = 0; k < 2; ++k) dst[m][k] = *(const LAS bf16x8*)(lds + PG8_SA(b, h) + aoff + m * 2048 + k * 1024); } } while (0)
#define PG8_LDB(dst, b, h) do { if constexpr (FP8) { _Pragma("unroll") for (int n = 0; n < 2; ++n) { const v4i32 _lo = *(const LAS v4i32*)(lds + PG8_SB(b, h) + boff + n * 2048), _hi = *(const LAS v4i32*)(lds + PG8_SB(b, h) + boff + n * 2048 + 1024); \
            dst##8[n] = __builtin_shufflevector(_lo, _hi, 0, 1, 2, 3, 4, 5, 6, 7); } } \
        else { _Pragma("unroll") for (int n = 0; n < 2; ++n) _Pragma("unroll") for (int k = 0; k < 2; ++k) dst[n][k] = *(const LAS bf16x8*)(lds + PG8_SB(b, h) + boff + n * 2048 + k * 1024); } } while (0)
#define PG8_MMA(ai, bj, At, Bt) do { __builtin_amdgcn_s_setprio(1); \
        if constexpr (PROBE == 1) { _Pragma("unroll") for (int m = 0; m < 4; ++m) _Pragma("unroll") for (int n = 0; n < 2; ++n) { acc[ai][bj][m][n][0] += __builtin_bit_cast(float, At##8[m][0] ^ Bt##8[n][1]); } } \
        else if constexpr (PROBE == 3) { _Pragma("unroll") for (int m = 0; m < 4; ++m) _Pragma("unroll") for (int n = 0; n < 2; ++n) { \
            const v4i32 _b0 = __builtin_shufflevector(Bt##8[n], Bt##8[n], 0, 1, 2, 3), _b1 = __builtin_shufflevector(Bt##8[n], Bt##8[n], 4, 5, 6, 7), _a0 = __builtin_shufflevector(At##8[m], At##8[m], 0, 1, 2, 3), _a1 = __builtin_shufflevector(At##8[m], At##8[m], 4, 5, 6, 7); \
            acc[ai][bj][m][n] = __builtin_amdgcn_mfma_f32_16x16x32_bf16(__builtin_bit_cast(bf16x8, _b0), __builtin_bit_cast(bf16x8, _a0), acc[ai][bj][m][n], 0, 0, 0); \
            acc[ai][bj][m][n] = __builtin_amdgcn_mfma_f32_16x16x32_bf16(__builtin_bit_cast(bf16x8, _b1), __builtin_bit_cast(bf16x8, _a1), acc[ai][bj][m][n], 0, 0, 0); } } \
        else if constexpr (FP8) { _Pragma("unroll") for (int m = 0; m < 4; ++m) _Pragma("unroll") for (int n = 0; n < 2; ++n) \
            acc[ai][bj][m][n] = __builtin_amdgcn_mfma_scale_f32_16x16x128_f8f6f4(Bt##8[n], At##8[m], acc[ai][bj][m][n], 0, 0, 0, MX_SCALE_W, 0, MX_SCALE_A); } \
        else { _Pragma("unroll") for (int m = 0; m < 4; ++m) _Pragma("unroll") for (int n = 0; n < 2; ++n) _Pragma("unroll") for (int k = 0; k < 2; ++k) \
            acc[ai][bj][m][n] = __builtin_amdgcn_mfma_f32_16x16x32_bf16(Bt[n][k], At[m][k], acc[ai][bj][m][n], 0, 0, 0); } \
        __builtin_amdgcn_s_setprio(0); } while (0)
#define PG8_WAIT_V(n) asm volatile("s_waitcnt vmcnt(" #n ")" ::: "memory")
#define PG8_WAIT_L(n) asm volatile("s_waitcnt lgkmcnt(" #n ")" ::: "memory")
#define PG8_BAR __builtin_amdgcn_s_barrier()
#define PG8_SCHED __builtin_amdgcn_sched_barrier(0)
    Unit cur, nxt; int ui = 0;
    if (!S.next(0, cur)) return;
    f32x4 acc[2][2][4][2];
    bf16x8 At[4][2], B0[2][2], B1[2][2]; v8i32 At8[4], B08[2], B18[2];
    const char* cA = S.a_ptr(cur); const char* cB = S.b_ptr(cur);
    if constexpr (Sched::GATHER) { S.a_voff(cur, vAc, sR, sC); }
    if constexpr (SP2) {
        PG8_STAGE(PG8_SB(0, 0), cB, voffB); PG8_STAGE(PG8_SB(0, 1), cB + hstepB, voffB); PG8_STAGE(PG8_SA(0, 0), cA, vAc[0]); PG8_STAGE(PG8_SA(0, 1), cA, vAc[1]);
        if (wr == 1) PG8_BAR;
        PG8_WAIT_V(2); PG8_BAR;
        PG8_STAGE(PG8_SB(1, 0), cB + kstepB, voffB); PG8_STAGE(PG8_SA(1, 0), cA + kstep, vAc[0]); PG8_STAGE(PG8_SB(1, 1), cB + hstepB + kstepB, voffB);
        PG8_WAIT_V(6); PG8_BAR;
    } else {
        PG8_STAGE(PG8_SB(0, 0), cB, voffB); PG8_STAGE(PG8_SA(0, 0), cA, vAc[0]); PG8_STAGE(PG8_SB(0, 1), cB + hstepB, voffB); PG8_STAGE(PG8_SA(0, 1), cA, vAc[1]);
        if (wr == 1) PG8_BAR;
        PG8_WAIT_V(4); PG8_BAR;
        PG8_STAGE(PG8_SB(1, 0), cB + kstepB, voffB); PG8_STAGE(PG8_SA(1, 0), cA + kstep, vAc[0]); PG8_STAGE(PG8_SB(1, 1), cB + hstepB + kstepB, voffB);
        PG8_WAIT_V(6); PG8_BAR;
    }
    constexpr bool LOOKAHEAD = Sched::GATHER || Epi::HAS_BIAS;
    bool has_next = false;
    int gtok[2][2]; f32x4 bpre[2][2];
    if constexpr (LOOKAHEAD) { has_next = S.next(1, nxt);
        if constexpr (Sched::GATHER) { if (has_next) S.a_tok(nxt, gtok, sR); }
        if constexpr (Epi::HAS_BIAS) E.load_bias(cur, wc, fq, bpre); }
    for (;;) {
        if constexpr (!LOOKAHEAD) has_next = S.next(ui + 1, nxt);
        const char* nA = has_next ? S.a_ptr(nxt) : cA; const char* nB = has_next ? S.b_ptr(nxt) : cB;
        if constexpr (Epi::HAS_BIAS) E.init_from(acc, bpre); else E.init(acc, cur, wc, fq);
        if constexpr (Sched::GATHER) { if (has_next) S.a_voff_from_tok(gtok, vAn, sC); }
        for (int t = 0; t < nt; t += 2) {
            const bool last = (t == nt - 2);
            const char* a1 = cA + (size_t)(t + 1) * kstep;
            const char* a2 = last ? nA : cA + (size_t)(t + 2) * kstep; const char* b2 = last ? nB : cB + (size_t)(t + 2) * kstepB;
            const char* a3 = a2 + kstep; const char* b3 = b2 + kstepB;
            if constexpr (SP2) {
            PG8_LDB(B0, 0, 0); PG8_LDB(B1, 0, 1); PG8_SCHED; PG8_LDA(At, 0, 0); PG8_STAGE(PG8_SA(1, 1), a1, vAc[1]);
            if constexpr (Sched::GATHER) { if (last && has_next) {
#pragma unroll
                for (int h = 0; h < 2; ++h)
#pragma unroll
                    for (int i = 0; i < 2; ++i) vAc[h][i] = vAn[h][i]; } }
            PG8_WAIT_V(8); PG8_WAIT_L(0); PG8_BAR; PG8_MMA(0, 0, At, B0); PG8_MMA(0, 1, At, B1); PG8_BAR; PG8_SCHED;
            PG8_LDA(At, 0, 1); PG8_STAGE(PG8_SB(0, 0), b2, voffB); PG8_STAGE(PG8_SB(0, 1), b2 + hstepB, voffB); PG8_STAGE(PG8_SA(0, 0), a2, vAc[0]);
            PG8_WAIT_V(8); PG8_WAIT_L(0); PG8_BAR; PG8_MMA(1, 0, At, B0); PG8_MMA(1, 1, At, B1); PG8_BAR; PG8_SCHED;
            PG8_LDB(B0, 1, 0); PG8_LDB(B1, 1, 1); PG8_SCHED; PG8_LDA(At, 1, 0); PG8_STAGE(PG8_SA(0, 1), a2, vAc[1]);
            PG8_WAIT_V(8); PG8_WAIT_L(0); PG8_BAR; PG8_MMA(0, 0, At, B0); PG8_MMA(0, 1, At, B1); PG8_BAR; PG8_SCHED;
            PG8_LDA(At, 1, 1); PG8_STAGE(PG8_SB(1, 0), b3, voffB); PG8_STAGE(PG8_SB(1, 1), b3 + hstepB, voffB); PG8_STAGE(PG8_SA(1, 0), a3, vAc[0]);
            PG8_WAIT_V(8); PG8_WAIT_L(0); PG8_BAR; PG8_MMA(1, 0, At, B0); PG8_MMA(1, 1, At, B1); PG8_BAR; PG8_SCHED;
            } else {
            PG8_LDB(B0, 0, 0); PG8_SCHED; PG8_LDA(At, 0, 0); PG8_STAGE(PG8_SA(1, 1), a1, vAc[1]);
            if constexpr (Sched::GATHER) { if (last && has_next) {
#pragma unroll
                for (int h = 0; h < 2; ++h)
#pragma unroll
                    for (int i = 0; i < 2; ++i) vAc[h][i] = vAn[h][i]; } }
            PG8_WAIT_L(8); PG8_BAR; PG8_WAIT_L(0); PG8_MMA(0, 0, At, B0); PG8_BAR; PG8_SCHED;
            PG8_LDB(B1, 0, 1); PG8_STAGE(PG8_SB(0, 0), b2, voffB);
            PG8_BAR; PG8_WAIT_L(0); PG8_MMA(0, 1, At, B1); PG8_BAR;
            PG8_LDA(At, 0, 1); PG8_STAGE(PG8_SA(0, 0), a2, vAc[0]);
            PG8_BAR; PG8_WAIT_L(0); PG8_MMA(1, 0, At, B0); PG8_BAR; PG8_SCHED;
            PG8_STAGE(PG8_SB(0, 1), b2 + hstepB, voffB);
            PG8_WAIT_V(6); PG8_BAR; PG8_MMA(1, 1, At, B1); PG8_BAR;
            PG8_LDB(B0, 1, 0); PG8_SCHED; PG8_LDA(At, 1, 0); PG8_STAGE(PG8_SA(0, 1), a2, vAc[1]);
            PG8_WAIT_L(8); PG8_BAR; PG8_WAIT_L(0); PG8_MMA(0, 0, At, B0); PG8_BAR; PG8_SCHED;
            PG8_LDB(B1, 1, 1); PG8_STAGE(PG8_SB(1, 0), b3, voffB);
            PG8_BAR; PG8_WAIT_L(0); PG8_MMA(0, 1, At, B1); PG8_BAR;
            PG8_LDA(At, 1, 1); PG8_STAGE(PG8_SA(1, 0), a3, vAc[0]);
            PG8_BAR; PG8_WAIT_L(0); PG8_MMA(1, 0, At, B0); PG8_BAR; PG8_SCHED;
            PG8_STAGE(PG8_SB(1, 1), b3 + hstepB, voffB);
            PG8_WAIT_V(6); PG8_BAR; PG8_MMA(1, 1, At, B1); PG8_BAR;
            }
        }
        if constexpr (ALIGN_EPI) { if (wr == 0) PG8_BAR; }
        if constexpr (PROBE == 7) { f32x4 s_ = acc[0][0][0][0];
#pragma unroll
            for (int a = 0; a < 2; ++a)
#pragma unroll
                for (int b = 0; b < 2; ++b)
#pragma unroll
                    for (int m = 0; m < 4; ++m)
#pragma unroll
                        for (int n = 0; n < 2; ++n) s_ = s_ + acc[a][b][m][n];
            if (s_[0] + s_[1] + s_[2] + s_[3] == 1.2345678f) *(volatile float*)S.a_ptr(cur) = s_[0]; }
        Unit nn; bool has2 = false;
        if constexpr (LOOKAHEAD) { has2 = has_next && S.next(ui + 2, nn);
            if constexpr (Epi::HAS_BIAS) { if (has_next) E.load_bias(nxt, wc, fq, bpre); }
            if constexpr (Sched::GATHER) { if (has2) S.a_tok(nn, gtok, sR); } }
        if constexpr (PROBE != 6 && PROBE != 7) E(acc, cur, wr, wc, fr, fq);
        if (!has_next) break;
        cur = nxt; cA = nA; cB = nB; ++ui;
        if constexpr (LOOKAHEAD) { nxt = nn; has_next = has2; }
        if constexpr (ALIGN_EPI) { if (wr == 1) PG8_BAR; }
    }
    PG8_WAIT_V(0);
    if constexpr (!ALIGN_EPI) { if (wr == 0) PG8_BAR; }
    PG8_BAR;
#undef PG8_SA
#undef PG8_SB
#undef PG8_STAGE
#undef PG8_LDA
#undef PG8_LDB
#undef PG8_MMA
#undef PG8_WAIT_V
#undef PG8_WAIT_L
#undef PG8_BAR
#undef PG8_SCHED
}
}
using pg8::Unit;
struct DenseSched {
    static constexpr bool GATHER = false;
    const char* A; const char* Bt; int lda, ldb, nM, nN, G, c;
    __device__ __forceinline__ bool next(int i, Unit& u) const { const int L = i * G + c; if (L >= nM * nN) return false; pg8::tile_order(L, nM, nN, u.pm, u.pn); u.e = 0; u.aux = 0; return true; }
    __device__ __forceinline__ const char* a_ptr(const Unit& u) const { return A + (size_t)u.pm * 256 * lda * 2; }
    __device__ __forceinline__ const char* b_ptr(const Unit& u) const { return Bt + (size_t)u.pn * 256 * ldb * 2; }
};
struct ProjSched {
    static constexpr bool GATHER = false;
    const char* A; const char* Bt; const char* A2; const char* Bt2; int G, c;
    __device__ __forceinline__ bool next(int i, Unit& u) const { const int L = i * G + c; constexpr int n1 = 32 * 26;
        if (L < n1) { pg8::tile_order(L, 32, 26, u.pm, u.pn); u.e = 0; u.aux = 0; return true; }
        if (L < n1 + 8) { u.pm = (L - n1) >> 2; u.pn = (L - n1) & 3; u.e = 1; u.aux = 0; return true; }
        return false; }
    __device__ __forceinline__ const char* a_ptr(const Unit& u) const { return (u.e ? A2 : A) + (size_t)u.pm * 256 * 2048 * 2; }
    __device__ __forceinline__ const char* b_ptr(const Unit& u) const { return (u.e ? Bt2 : Bt) + (size_t)u.pn * 256 * 2048 * 2; }
};
struct PoolSched {
    static constexpr bool GATHER = false;
    const char* A; const char* Bt; int G, c;
    __device__ __forceinline__ bool next(int i, Unit& u) const { const int L = i * G + c; if (L >= 128) return false; u.pm = L >> 2; u.pn = L & 3; u.e = 0; u.aux = 0; return true; }
    __device__ __forceinline__ const char* a_ptr(const Unit& u) const { return A + ((size_t)u.pm * 256 * 1024 + u.pn * 256) * 2; }
    __device__ __forceinline__ const char* b_ptr(const Unit& u) const { return Bt + (size_t)u.pn * 256 * 256 * 2; }
};
struct MixSched {
    static constexpr bool GATHER = false;
    const char* A0; const char* B0; const char* A1; const char* B1; int G, c;
    __device__ __forceinline__ bool next(int i, Unit& u) const { const int L = (i >> 1) * G + c; if (L >= 32 * 8) return false; pg8::tile_order(L, 32, 8, u.pm, u.pn); u.e = i & 1; u.aux = 0; return true; }
    __device__ __forceinline__ const char* a_ptr(const Unit& u) const { return (u.e ? A1 : A0) + (size_t)u.pm * 256 * 1024 * 2; }
    __device__ __forceinline__ const char* b_ptr(const Unit& u) const { return (u.e ? B1 : B0) + (size_t)u.pn * 256 * 1024 * 2; }
};
struct MoeTab { const LAS int* tstart; const LAS int* cnt; const LAS int* tile_e; };
template <int NPN> __device__ __forceinline__ bool moe_unit(const MoeTab& T, int i, int G, int c, Unit& u) {
    const int NU = __builtin_amdgcn_readfirstlane(T.tstart[32]) * NPN; int L;
    if ((G & 7) == 0) { const int x = c & 7, j = c >> 3, per = G >> 3, lo = (int)(((long)NU * x) >> 3), hi = (int)(((long)NU * (x + 1)) >> 3); L = lo + j + i * per; if (L >= hi) return false; }
    else { L = i * G + c; if (L >= NU) return false; }
    const int tau_lin = L / NPN;
    const int e = __builtin_amdgcn_readfirstlane(T.tile_e[tau_lin]); const int ts0 = __builtin_amdgcn_readfirstlane(T.tstart[e]), ts1 = __builtin_amdgcn_readfirstlane(T.tstart[e + 1]);
    const int v = L - ts0 * NPN, nte = ts1 - ts0;
    u.e = e; u.pn = v / nte; u.aux = v - u.pn * nte; u.pm = ts0 + u.aux; return true;
}
struct Moe1Sched {
    static constexpr bool GATHER = true;
    const char* A; const char* Bt; const int* list_tok; MoeTab T; int G, c; int pflag = 0;
    __device__ __forceinline__ bool next(int i, Unit& u) const { return moe_unit<16>(T, i, G, c, u); }
    __device__ __forceinline__ const char* a_ptr(const Unit&) const { return A; }
    __device__ __forceinline__ const char* b_ptr(const Unit& u) const { if (pflag & 1) return Bt; return Bt + ((size_t)u.e * 16 + (size_t)u.pn) * (16 * 32768); }
    __device__ __forceinline__ void a_tok(const Unit& u, int (&tk)[2][2], const int (&sR)[2]) const {
        const int cnt = __builtin_amdgcn_readfirstlane(T.cnt[u.e]); const int* lst = list_tok + (size_t)u.e * ECAP;
#pragma unroll
        for (int h = 0; h < 2; ++h)
#pragma unroll
            for (int i = 0; i < 2; ++i) { int pos = u.aux * 256 + h * 128 + sR[i]; pos = pos < cnt ? pos : cnt - 1; tk[h][i] = (pflag & 2) ? (h * 128 + sR[i]) : lst[pos]; }
    }
    __device__ __forceinline__ void a_voff_from_tok(const int (&tk)[2][2], unsigned (&v)[2][2], const int (&sC)[2]) const {
#pragma unroll
        for (int h = 0; h < 2; ++h)
#pragma unroll
            for (int i = 0; i < 2; ++i) v[h][i] = (unsigned)(tk[h][i] * F8_PITCH + sC[i] * 2);
    }
    __device__ __forceinline__ void a_voff(const Unit& u, unsigned (&v)[2][2], const int (&sR)[2], const int (&sC)[2]) const { int tk[2][2]; a_tok(u, tk, sR); a_voff_from_tok(tk, v, sC); }
};
struct Moe2Sched {
    static constexpr bool GATHER = true;
    const char* A; const char* Bt; MoeTab T; int G, c;
    __device__ __forceinline__ bool next(int i, Unit& u) const { return moe_unit<8>(T, i, G, c, u); }
    __device__ __forceinline__ const char* a_ptr(const Unit&) const { return A; }
    __device__ __forceinline__ const char* b_ptr(const Unit& u) const { return Bt + ((size_t)u.e * 8 + (size_t)u.pn) * (16 * 32768); }
    __device__ __forceinline__ void a_tok(const Unit& u, int (&tk)[2][2], const int (&sR)[2]) const {
#pragma unroll
        for (int h = 0; h < 2; ++h)
#pragma unroll
            for (int i = 0; i < 2; ++i) tk[h][i] = u.pm * 256 + h * 128 + sR[i];
    }
    __device__ __forceinline__ void a_voff_from_tok(const int (&tk)[2][2], unsigned (&v)[2][2], const int (&sC)[2]) const {
#pragma unroll
        for (int h = 0; h < 2; ++h)
#pragma unroll
            for (int i = 0; i < 2; ++i) v[h][i] = (unsigned)(tk[h][i] * F8_PITCH + sC[i] * 2);
    }
    __device__ __forceinline__ void a_voff(const Unit& u, unsigned (&v)[2][2], const int (&sR)[2], const int (&sC)[2]) const { int tk[2][2]; a_tok(u, tk, sR); a_voff_from_tok(tk, v, sC); }
};

#define EPI_LOOP_ROWS for (int ai = 0; ai < 2; ++ai) _Pragma("unroll") for (int m = 0; m < 4; ++m)
struct EpiProj {
    static constexpr bool PERM = true; static constexpr bool HAS_BIAS = false;
    __device__ __forceinline__ void init(f32x4 (&acc)[2][2][4][2], const Unit&, int, int) const {
#pragma unroll
        for (int a = 0; a < 2; ++a)
#pragma unroll
            for (int b = 0; b < 2; ++b)
#pragma unroll
                for (int m = 0; m < 4; ++m)
#pragma unroll
                    for (int n = 0; n < 2; ++n) acc[a][b][m][n] = (f32x4){0.f, 0.f, 0.f, 0.f}; }
    bf16_t* proj; bf16_t* kvc;
    __device__ __forceinline__ void operator()(const f32x4 (&acc)[2][2][4][2], const Unit& u, int wr, int wc, int fr, int fq) const {
        const bool sg = (u.e == 0) && (u.pn >= 10); const int ldc = u.e ? 1024 : IN_WIDTH; bf16_t* base = (u.e ? kvc : proj) + (size_t)(u.pm * 256 + wr * 64 + fr) * ldc + u.pn * 256 + wc * 32 + 8 * fq;
#pragma unroll
        EPI_LOOP_ROWS { bf16_t* rowp = base + (size_t)(ai * 128 + m * 16) * ldc;
#pragma unroll
            for (int bj = 0; bj < 2; ++bj) { f32x4 v0 = acc[ai][bj][m][0], v1 = acc[ai][bj][m][1];
                if (sg) { v0 = (f32x4){sigmoidf_(v0[0]), sigmoidf_(v0[1]), sigmoidf_(v0[2]), sigmoidf_(v0[3])}; v1 = (f32x4){sigmoidf_(v1[0]), sigmoidf_(v1[1]), sigmoidf_(v1[2]), sigmoidf_(v1[3])}; }
                u32x4 w; w.x = cvt_pk_bf16(v0[0], v0[1]); w.y = cvt_pk_bf16(v0[2], v0[3]); w.z = cvt_pk_bf16(v1[0], v1[1]); w.w = cvt_pk_bf16(v1[2], v1[3]);
                *(u32x4*)(rowp + bj * 128) = w; } }
    }
};
template <int MODE  > struct EpiBf16 {
    static constexpr bool PERM = true; static constexpr bool HAS_BIAS = false;
    __device__ __forceinline__ void init(f32x4 (&acc)[2][2][4][2], const Unit&, int, int) const {
#pragma unroll
        for (int a = 0; a < 2; ++a)
#pragma unroll
            for (int b = 0; b < 2; ++b)
#pragma unroll
                for (int m = 0; m < 4; ++m)
#pragma unroll
                    for (int n = 0; n < 2; ++n) acc[a][b][m][n] = (f32x4){0.f, 0.f, 0.f, 0.f}; }
    bf16_t* O; int ldc; int col_mul;
    const float* cscale; const LAS float* rscale;
    __device__ __forceinline__ void operator()(const f32x4 (&acc)[2][2][4][2], const Unit& u, int wr, int wc, int fr, int fq) const {
        const int col0 = u.pn * col_mul + wc * 32 + 8 * fq; bf16_t* base = O + (size_t)(u.pm * 256 + wr * 64 + fr) * ldc + col0;
        f32x4 cs[2][2];
        if (MODE == 1) {
#pragma unroll
            for (int bj = 0; bj < 2; ++bj)
#pragma unroll
                for (int n = 0; n < 2; ++n) cs[bj][n] = *(const f32x4*)(cscale + col0 + bj * 128 + 4 * n); }
#pragma unroll
        EPI_LOOP_ROWS { bf16_t* rowp = base + (size_t)(ai * 128 + m * 16) * ldc; float rs = 1.f; if (MODE == 2) rs = rscale[ai * 128 + wr * 64 + m * 16 + fr];
#pragma unroll
            for (int bj = 0; bj < 2; ++bj) { f32x4 v0 = acc[ai][bj][m][0], v1 = acc[ai][bj][m][1];
                if (MODE == 1) { v0 = v0 * cs[bj][0]; v1 = v1 * cs[bj][1]; }
                if (MODE == 2) { v0 = v0 * rs; v1 = v1 * rs; }
                u32x4 w; w.x = cvt_pk_bf16(v0[0], v0[1]); w.y = cvt_pk_bf16(v0[2], v0[3]); w.z = cvt_pk_bf16(v1[0], v1[1]); w.w = cvt_pk_bf16(v1[2], v1[3]);
                *(u32x4*)(rowp + bj * 128) = w; } }
    }
};
struct EpiMix {
    static constexpr bool PERM = true; static constexpr bool HAS_BIAS = false;
    __device__ __forceinline__ void init(f32x4 (&acc)[2][2][4][2], const Unit&, int, int) const {
#pragma unroll
        for (int a = 0; a < 2; ++a)
#pragma unroll
            for (int b = 0; b < 2; ++b)
#pragma unroll
                for (int m = 0; m < 4; ++m)
#pragma unroll
                    for (int n = 0; n < 2; ++n) acc[a][b][m][n] = (f32x4){0.f, 0.f, 0.f, 0.f}; }
    const bf16_t* proj; bf16_t* scratch; bf16_t* mixed;
    __device__ __forceinline__ void operator()(const f32x4 (&acc)[2][2][4][2], const Unit& u, int wr, int wc, int fr, int fq) const {
        const int row0 = u.pm * 256 + wr * 64 + fr, col0 = u.pn * 256 + wc * 32 + 8 * fq;
        const bf16_t* gbase = proj + (size_t)row0 * IN_WIDTH + (u.e ? GA_END : P_END) + col0;
#pragma unroll
        EPI_LOOP_ROWS { const size_t ro = (size_t)(ai * 128 + m * 16);
#pragma unroll
            for (int bj = 0; bj < 2; ++bj) { const u32x4 gw = *(const u32x4*)(gbase + ro * IN_WIDTH + bj * 128);
                f32x4 v0 = acc[ai][bj][m][0] * (f32x4){bf_lo(gw.x), bf_hi(gw.x), bf_lo(gw.y), bf_hi(gw.y)}, v1 = acc[ai][bj][m][1] * (f32x4){bf_lo(gw.z), bf_hi(gw.z), bf_lo(gw.w), bf_hi(gw.w)};
                bf16_t* sp = scratch + ((size_t)row0 + ro) * D_MODEL + col0 + bj * 128;
                if (u.e == 0) { u32x4 w; w.x = cvt_pk_bf16(v0[0], v0[1]); w.y = cvt_pk_bf16(v0[2], v0[3]); w.z = cvt_pk_bf16(v1[0], v1[1]); w.w = cvt_pk_bf16(v1[2], v1[3]); *(u32x4*)sp = w; }
                else { const u32x4 t = *(const u32x4*)sp; v0 = v0 + (f32x4){bf_lo(t.x), bf_hi(t.x), bf_lo(t.y), bf_hi(t.y)}; v1 = v1 + (f32x4){bf_lo(t.z), bf_hi(t.z), bf_lo(t.w), bf_hi(t.w)};
                    u32x4 w; w.x = cvt_pk_bf16(v0[0], v0[1]); w.y = cvt_pk_bf16(v0[2], v0[3]); w.z = cvt_pk_bf16(v1[0], v1[1]); w.w = cvt_pk_bf16(v1[2], v1[3]);
                    *(u32x4*)(mixed + ((size_t)row0 + ro) * D_MODEL + col0 + bj * 128) = w; } } }
    }
};
template <bool RES_BF16, bool SS> struct EpiResid {
    static constexpr bool PERM = false; static constexpr bool HAS_BIAS = false;
    __device__ __forceinline__ void init(f32x4 (&acc)[2][2][4][2], const Unit&, int, int) const {
#pragma unroll
        for (int a = 0; a < 2; ++a)
#pragma unroll
            for (int b = 0; b < 2; ++b)
#pragma unroll
                for (int m = 0; m < 4; ++m)
#pragma unroll
                    for (int n = 0; n < 2; ++n) acc[a][b][m][n] = (f32x4){0.f, 0.f, 0.f, 0.f}; }
    const void* resid; bf16_t* ob; float* ss;
    __device__ __forceinline__ void operator()(const f32x4 (&acc)[2][2][4][2], const Unit& u, int wr, int wc, int fr, int fq) const {
        const int row0 = u.pm * 256 + wr * 64 + fr, col0 = u.pn * 256 + wc * 32 + 4 * fq;
#pragma unroll
        EPI_LOOP_ROWS { const size_t off = (size_t)(row0 + ai * 128 + m * 16) * D_MODEL + col0; float s = 0.f;
#pragma unroll
            for (int bj = 0; bj < 2; ++bj)
#pragma unroll
                for (int n = 0; n < 2; ++n) { f32x4 r;
                    if (RES_BF16) { const u32x2 t = *(const u32x2*)((const bf16_t*)resid + off + bj * 128 + n * 16); r = (f32x4){bf_lo(t.x), bf_hi(t.x), bf_lo(t.y), bf_hi(t.y)}; }
                    else r = *(const f32x4*)((const float*)resid + off + bj * 128 + n * 16);
                    const f32x4 v = acc[ai][bj][m][n] + r;
                    if (SS) s += (v[0] * v[0] + v[1] * v[1]) + (v[2] * v[2] + v[3] * v[3]);
                    u32x2 w; w.x = cvt_pk_bf16(v[0], v[1]); w.y = cvt_pk_bf16(v[2], v[3]); *(u32x2*)(ob + off + bj * 128 + n * 16) = w; }
            if (SS) { s += __shfl_xor(s, 16); s += __shfl_xor(s, 32); if (fq == 0) ss[(size_t)(row0 + ai * 128 + m * 16) * 32 + u.pn * 4 + wc] = s; } }
    }
};
struct EpiSwiglu {
    static constexpr bool PERM = true; static constexpr int NB = 4096; static constexpr bool HAS_BIAS = true;
    __device__ __forceinline__ void load_bias(const Unit& u, int wc, int fq, f32x4 (&b)[2][2]) const {
        const float* bp = bias + (size_t)u.e * NB + u.pn * 256 + wc * 32 + 8 * fq;
#pragma unroll
        for (int bj = 0; bj < 2; ++bj)
#pragma unroll
            for (int n = 0; n < 2; ++n) b[bj][n] = *(const f32x4*)(bp + bj * 128 + 4 * n); }
    __device__ __forceinline__ void init_from(f32x4 (&acc)[2][2][4][2], const f32x4 (&b)[2][2]) const {
#pragma unroll
        for (int a = 0; a < 2; ++a)
#pragma unroll
            for (int bj = 0; bj < 2; ++bj)
#pragma unroll
                for (int m = 0; m < 4; ++m)
#pragma unroll
                    for (int n = 0; n < 2; ++n) acc[a][bj][m][n] = b[bj][n]; }
    const float* bias; unsigned char* act; int pflag = 0;
    __device__ __forceinline__ void init(f32x4 (&acc)[2][2][4][2], const Unit& u, int wc, int fq) const {
        const float* bp = bias + (size_t)u.e * NB + u.pn * 256 + wc * 32 + 8 * fq;
#pragma unroll
        for (int b = 0; b < 2; ++b)
#pragma unroll
            for (int n = 0; n < 2; ++n) { const f32x4 bv = *(const f32x4*)(bp + b * 128 + 4 * n);
#pragma unroll
                for (int a = 0; a < 2; ++a)
#pragma unroll
                    for (int m = 0; m < 4; ++m) acc[a][b][m][n] = bv; } }
    __device__ __forceinline__ void operator()(const f32x4 (&acc)[2][2][4][2], const Unit& u, int wr, int wc, int fr, int fq) const {
        const int hc0 = u.pn * 256 + wc * 32 + 8 * fq;
        unsigned char* base = act + (size_t)(u.pm * 256 + wr * 64 + fr) * F8_PITCH + (hc0 >> 1);
#pragma unroll
        EPI_LOOP_ROWS { unsigned char* rowp = base + (size_t)(ai * 128 + m * 16) * F8_PITCH;
#pragma unroll
            for (int bj = 0; bj < 2; ++bj) { const f32x4 v0 = acc[ai][bj][m][0], v1 = acc[ai][bj][m][1]; float o[4];
                const float g[4] = {v0[0], v0[2], v1[0], v1[2]}, l[4] = {v0[1], v0[3], v1[1], v1[3]};
#pragma unroll
                for (int j = 0; j < 4; ++j) { const float xg = fminf(g[j], 7.f), xl = fminf(fmaxf(l[j], -7.f), 7.f); o[j] = xg * sigmoidf_(1.702f * xg) * (xl + 1.f); }
                const unsigned pk = pack4_fp8(o[0], o[1], o[2], o[3]); if (!(pflag & 1) || pk == 0x12345678u) *(unsigned*)(rowp + bj * 64) = pk; } }
    }
};
struct EpiDown {
    static constexpr bool PERM = true; static constexpr int NB = 2048; static constexpr bool HAS_BIAS = true;
    __device__ __forceinline__ void load_bias(const Unit& u, int wc, int fq, f32x4 (&b)[2][2]) const {
        const float* bp = bias + (size_t)u.e * NB + u.pn * 256 + wc * 32 + 8 * fq;
#pragma unroll
        for (int bj = 0; bj < 2; ++bj)
#pragma unroll
            for (int n = 0; n < 2; ++n) b[bj][n] = *(const f32x4*)(bp + bj * 128 + 4 * n); }
    __device__ __forceinline__ void init_from(f32x4 (&acc)[2][2][4][2], const f32x4 (&b)[2][2]) const {
#pragma unroll
        for (int a = 0; a < 2; ++a)
#pragma unroll
            for (int bj = 0; bj < 2; ++bj)
#pragma unroll
                for (int m = 0; m < 4; ++m)
#pragma unroll
                    for (int n = 0; n < 2; ++n) acc[a][bj][m][n] = b[bj][n]; }
    const float* bias; unsigned char* ys;
    __device__ __forceinline__ void init(f32x4 (&acc)[2][2][4][2], const Unit& u, int wc, int fq) const {
        const float* bp = bias + (size_t)u.e * NB + u.pn * 256 + wc * 32 + 8 * fq;
#pragma unroll
        for (int b = 0; b < 2; ++b)
#pragma unroll
            for (int n = 0; n < 2; ++n) { const f32x4 bv = *(const f32x4*)(bp + b * 128 + 4 * n);
#pragma unroll
                for (int a = 0; a < 2; ++a)
#pragma unroll
                    for (int m = 0; m < 4; ++m) acc[a][b][m][n] = bv; } }
    __device__ __forceinline__ void operator()(const f32x4 (&acc)[2][2][4][2], const Unit& u, int wr, int wc, int fr, int fq) const {
        const int col0 = u.pn * 256 + wc * 32 + 8 * fq;
        unsigned char* base = ys + (size_t)(u.pm * 256 + wr * 64 + fr) * D_MODEL + col0;
#pragma unroll
        EPI_LOOP_ROWS { unsigned char* rowp = base + (size_t)(ai * 128 + m * 16) * D_MODEL;
#pragma unroll
            for (int bj = 0; bj < 2; ++bj) { const f32x4 v0 = acc[ai][bj][m][0], v1 = acc[ai][bj][m][1];
                u32x2 w; w.x = pack4_fp8(v0[0], v0[1], v0[2], v0[3]); w.y = pack4_fp8(v1[0], v1[1], v1[2], v1[3]);
                *(u32x2*)(rowp + bj * 128) = w; } }
    }
};
namespace attn {
constexpr int D = 128, NW = 8, QBLK = 32, KVBLK = 64, SDEPTH = 2;
constexpr float SCALE = 0.088388347648318440f, THR = 8.f;
constexpr size_t SHM_V = KVBLK * D * 2, SHM_K = KVBLK * D * 2, SHM_ATTN = 2 * SHM_V + 2 * SHM_K + NW * 64 * 4;
#define KSWZ(row, colB) ((row) * 256 + ((colB) ^ (((row) & 7) << 4)))
#define SBAR() __builtin_amdgcn_sched_barrier(0)
__device__ __forceinline__ int crow(int r, int hi) { return (r & 3) + 8 * (r >> 2) + 4 * hi; }
__device__ __forceinline__ void partialSM(f32x16& p0, f32x16& p1, float& m_reg, float& mn, float& alpha) {
  constexpr float C = SCALE * 1.4426950408889634f;
  float pmax = p0[0]; for (int r = 1; r < 16; ++r) pmax = fmaxf(pmax, p0[r]); for (int r = 0; r < 16; ++r) pmax = fmaxf(pmax, p1[r]);
  { auto rr = __builtin_amdgcn_permlane32_swap(__float_as_uint(pmax), __float_as_uint(pmax), false, false);
    pmax = fmaxf(__uint_as_float(rr[0]), __uint_as_float(rr[1])); }
  if (__builtin_expect(__all(pmax - m_reg <= THR / SCALE), 1)) { mn = m_reg; alpha = 1.f; }
  else { mn = fmaxf(m_reg, pmax); alpha = __builtin_amdgcn_exp2f((m_reg - mn) * C); m_reg = mn; }
  float mnC = -mn * C;
  for (int r = 0; r < 16; ++r) p0[r] = fmaf(p0[r], C, mnC); for (int r = 0; r < 16; ++r) p1[r] = fmaf(p1[r], C, mnC);
  for (int r = 0; r < 16; ++r) p0[r] = __builtin_amdgcn_exp2f(p0[r]);
}
__device__ __forceinline__ void finishSM(f32x16& p0, f32x16& p1, float alpha, float& l_reg, bf16x8& pa0, bf16x8& pa1, bf16x8& pa2, bf16x8& pa3) {
  for (int r = 0; r < 16; ++r) p1[r] = __builtin_amdgcn_exp2f(p1[r]);
  float ps = 0; for (int r = 0; r < 16; ++r) ps += p0[r]; for (int r = 0; r < 16; ++r) ps += p1[r];
  { auto rr = __builtin_amdgcn_permlane32_swap(__float_as_uint(ps), __float_as_uint(ps), false, false);
    ps = __uint_as_float(rr[0]) + __uint_as_float(rr[1]); }
  l_reg = l_reg * alpha + ps;
#define PK4(P, BASE, OUT) do { unsigned a0 = cvt_pk_bf16(P[BASE + 0], P[BASE + 1]), a1 = cvt_pk_bf16(P[BASE + 2], P[BASE + 3]);   \
    unsigned b0 = cvt_pk_bf16(P[BASE + 4], P[BASE + 5]), b1 = cvt_pk_bf16(P[BASE + 6], P[BASE + 7]);                              \
    auto r0 = __builtin_amdgcn_permlane32_swap(a0, b0, false, false); auto r1 = __builtin_amdgcn_permlane32_swap(a1, b1, false, false); \
    u32x4 w = {r0[0], r1[0], r0[1], r1[1]}; OUT = *reinterpret_cast<bf16x8*>(&w); } while (0)
  PK4(p0, 0, pa0); PK4(p0, 8, pa1); PK4(p1, 0, pa2); PK4(p1, 8, pa3);
#undef PK4
}
__device__ __forceinline__ void qkt(f32x16& p0, f32x16& p1, const bf16_t* Ks, const bf16x8* qr, int r32, int hi) {
  p0 = f32x16{}; p1 = f32x16{};
  for (int d0 = 0; d0 < 8; ++d0) { int cb = (d0 * 16 + hi * 8) * 2;
    bf16x8 b0 = *reinterpret_cast<const bf16x8*>((const char*)Ks + KSWZ(r32, cb));
    bf16x8 b1 = *reinterpret_cast<const bf16x8*>((const char*)Ks + KSWZ(32 + r32, cb));
    p0 = __builtin_amdgcn_mfma_f32_32x32x16_bf16(b0, qr[d0], p0, 0, 0, 0);
    p1 = __builtin_amdgcn_mfma_f32_32x32x16_bf16(b1, qr[d0], p1, 0, 0, 0); }
}
__device__ __forceinline__ int v_st(int k, int c) { const int kk = (k & ~0xC) | ((k & 4) << 1) | ((k & 8) >> 1); return ((kk >> 3) * 4 + (c >> 5)) * 512 + ((kk & 7) * 32 + (c & 31)) * 2; }
__device__ __forceinline__ int v_rd_base(int lane) { return ((lane & 3) << 3) | (((lane >> 2) & 3) << 6) | (((lane >> 4) & 1) << 5) | (((lane >> 5) & 1) << 8); }
constexpr int v_rd_off(int d0, int ks, int half) { return d0 * 512 + ks * 4096 + half * 2048; }
template <int OFF> __device__ __forceinline__ s16x4 tr_read(int vb) {
  s16x4 r; asm volatile("ds_read_b64_tr_b16 %0, %1 offset:%2" : "=&v"(r) : "v"(vb), "i"(OFF) : "memory"); return r;
}
template <int D0> __device__ __forceinline__ void pv_one(f32x16& od, int vb, bf16x8 pa0, bf16x8 pa1, bf16x8 pa2, bf16x8 pa3) {
  const s16x4 l0 = tr_read<v_rd_off(D0, 0, 0)>(vb), h0 = tr_read<v_rd_off(D0, 0, 1)>(vb), l1 = tr_read<v_rd_off(D0, 1, 0)>(vb), h1 = tr_read<v_rd_off(D0, 1, 1)>(vb);
  const s16x4 l2 = tr_read<v_rd_off(D0, 2, 0)>(vb), h2 = tr_read<v_rd_off(D0, 2, 1)>(vb), l3 = tr_read<v_rd_off(D0, 3, 0)>(vb), h3 = tr_read<v_rd_off(D0, 3, 1)>(vb);
  asm volatile("s_waitcnt lgkmcnt(0)" ::: "memory"); SBAR();
#define PK(L, H) (bf16x8){L[0], L[1], L[2], L[3], H[0], H[1], H[2], H[3]}
  od = __builtin_amdgcn_mfma_f32_32x32x16_bf16(pa0, PK(l0, h0), od, 0, 0, 0);
  od = __builtin_amdgcn_mfma_f32_32x32x16_bf16(pa1, PK(l1, h1), od, 0, 0, 0);
  od = __builtin_amdgcn_mfma_f32_32x32x16_bf16(pa2, PK(l2, h2), od, 0, 0, 0);
  od = __builtin_amdgcn_mfma_f32_32x32x16_bf16(pa3, PK(l3, h3), od, 0, 0, 0);
#undef PK
}
__device__ __forceinline__ void pv_d0(f32x16* o, int vb, bf16x8 pa0, bf16x8 pa1, bf16x8 pa2, bf16x8 pa3) {
  pv_one<0>(o[0], vb, pa0, pa1, pa2, pa3); pv_one<1>(o[1], vb, pa0, pa1, pa2, pa3); pv_one<2>(o[2], vb, pa0, pa1, pa2, pa3); pv_one<3>(o[3], vb, pa0, pa1, pa2, pa3);
}
template <int LDQ, int LDK, int LDO>
__device__ __forceinline__ void attn_dense_body(const bf16_t* __restrict__ Qb, const bf16_t* __restrict__ Kh, const bf16_t* __restrict__ Vh, bf16_t* __restrict__ Ob, int seq, char* lds) {
  const int tid = threadIdx.x, wid = tid >> 6, lane = tid & 63, r32 = lane & 31, hi = lane >> 5;
  bf16_t* V_lds = (bf16_t*)lds; bf16_t* K_lds = (bf16_t*)(lds + 2 * SHM_V);
  float* ws = (float*)(lds + 2 * SHM_V + 2 * SHM_K) + wid * 64; float* li_l = ws; float* al_l = ws + 32;
  float m_reg = -1e30f, l_reg = 0; f32x16 o[4] = {}; bf16x8 qr[8];
  const bf16_t* Qw = Qb + (long)(wid * QBLK + r32) * LDQ + hi * 8;
#pragma unroll
  for (int d0 = 0; d0 < 8; ++d0) qr[d0] = *reinterpret_cast<const bf16x8*>(Qw + d0 * 16);
  const int sr = tid >> 4, sc = (tid & 15) * 8, vst0 = v_st(sr, sc), vst1 = v_st(32 + sr, sc);
  const int vb0 = (int)(uintptr_t)V_lds + v_rd_base(lane);
  struct { bf16x8 vs0, vs1, ks0, ks1; } sr_[SDEPTH];
#define SLOAD(i, k0) do { sr_[i].vs0 = *reinterpret_cast<const bf16x8*>(&Vh[(long)((k0) + sr) * LDK + sc]); sr_[i].vs1 = *reinterpret_cast<const bf16x8*>(&Vh[(long)((k0) + 32 + sr) * LDK + sc]); \
    sr_[i].ks0 = *reinterpret_cast<const bf16x8*>(&Kh[(long)((k0) + sr) * LDK + sc]); sr_[i].ks1 = *reinterpret_cast<const bf16x8*>(&Kh[(long)((k0) + 32 + sr) * LDK + sc]); } while (0)
#define SWRITE(b, i) do { *(bf16x8*)((char*)V_lds + (b) * SHM_V + vst0) = sr_[i].vs0;          \
    *(bf16x8*)((char*)V_lds + (b) * SHM_V + vst1) = sr_[i].vs1; int kc = sc * 2;               \
    *(bf16x8*)((char*)K_lds + (b) * SHM_K + KSWZ(sr, kc)) = sr_[i].ks0;                       \
    *(bf16x8*)((char*)K_lds + (b) * SHM_K + KSWZ(32 + sr, kc)) = sr_[i].ks1; } while (0)
#define SWAIT() asm volatile("s_waitcnt vmcnt(4)" ::: "memory")
#define RESC(a) do { if (__any((a) < 1.f)) { if (hi == 0) al_l[r32] = (a); asm volatile("s_waitcnt lgkmcnt(0)" ::: "memory"); \
    for (int d = 0; d < 4; ++d) for (int r = 0; r < 16; ++r) o[d][r] *= al_l[crow(r, hi)]; } } while (0)
  f32x16 pA0, pA1, pB0, pB1; float mnA, mnB, alA, alB; bf16x8 pa0, pa1, pa2, pa3; const int NT = seq / KVBLK;
  constexpr int SE = 0, SO = SDEPTH - 1;
  SLOAD(SE, 0); asm volatile("s_waitcnt vmcnt(0)" ::: "memory"); SWRITE(0, SE); __syncthreads();
  qkt(pA0, pA1, K_lds, qr, r32, hi); partialSM(pA0, pA1, m_reg, mnA, alA);
  SLOAD(SO, KVBLK); if (2 < NT) SLOAD(SE, 2 * KVBLK);
  SWAIT(); SWRITE(1, SO); __syncthreads();
  for (int j = 1; j + 1 < NT; j += 2) {
    SBAR(); qkt(pB0, pB1, (bf16_t*)((char*)K_lds + SHM_K), qr, r32, hi);
    finishSM(pA0, pA1, alA, l_reg, pa0, pa1, pa2, pa3); SBAR();
    SLOAD(SO, (j + SDEPTH) * KVBLK); SBAR();
    pv_d0(o, vb0, pa0, pa1, pa2, pa3); partialSM(pB0, pB1, m_reg, mnB, alB);
    __syncthreads(); SWAIT(); SWRITE(0, SE);
    RESC(alB); __syncthreads();
    SBAR(); qkt(pA0, pA1, K_lds, qr, r32, hi);
    finishSM(pB0, pB1, alB, l_reg, pa0, pa1, pa2, pa3); SBAR();
    if (j + 3 < NT) SLOAD(SE, (j + 1 + SDEPTH) * KVBLK); SBAR();
    pv_d0(o, vb0 + (int)SHM_V, pa0, pa1, pa2, pa3); partialSM(pA0, pA1, m_reg, mnA, alA);
    __syncthreads(); SWAIT(); SWRITE(1, SO);
    RESC(alA); __syncthreads();
  }
  SBAR(); qkt(pB0, pB1, (bf16_t*)((char*)K_lds + SHM_K), qr, r32, hi);
  finishSM(pA0, pA1, alA, l_reg, pa0, pa1, pa2, pa3); SBAR();
  pv_d0(o, vb0, pa0, pa1, pa2, pa3); partialSM(pB0, pB1, m_reg, mnB, alB);
  __syncthreads(); RESC(alB);
  finishSM(pB0, pB1, alB, l_reg, pa0, pa1, pa2, pa3); SBAR();
  pv_d0(o, vb0 + (int)SHM_V, pa0, pa1, pa2, pa3);
  if (hi == 0) li_l[r32] = l_reg; asm volatile("s_waitcnt lgkmcnt(0)" ::: "memory");
  float rli[16];
#pragma unroll
  for (int r = 0; r < 16; ++r) rli[r] = __builtin_amdgcn_rcpf(li_l[crow(r, hi)]);
  bf16_t* Ow = Ob + (long)(wid * QBLK) * LDO;
#pragma unroll
  for (int r = 0; r < 16; ++r) { int orow = crow(r, hi);
    for (int d0 = 0; d0 < 4; ++d0) Ow[(long)orow * LDO + d0 * 32 + r32] = (bf16_t)(cvt_pk_bf16(o[d0][r] * rli[r], 0.f) & 0xffffu); }
  __syncthreads();
#undef SLOAD
#undef SWRITE
#undef SWAIT
#undef RESC
}
#undef KSWZ
}
constexpr size_t MiB = 1u << 20;
constexpr size_t al256(size_t x) { return (x + 255) / 256 * 256; }
constexpr size_t WS_CTL = 0, CTL_ZERO_BYTES = 64 * 1024;
constexpr size_t WS_WIN   = 1 * MiB;
constexpr size_t WS_WAU   = WS_WIN  + (size_t)IN_WIDTH * D_MODEL * 2;
constexpr size_t WS_WPU   = WS_WAU  + (size_t)D_MODEL * 1024 * 2;
constexpr size_t WS_WMO   = WS_WPU  + (size_t)D_MODEL * 1024 * 2;
constexpr size_t WS_WCQ   = WS_WMO  + (size_t)D_MODEL * D_MODEL * 2;
constexpr size_t WS_WCKV  = WS_WCQ  + (size_t)MEM_WIDTH * D_MODEL * 2;
constexpr size_t WS_WCO   = WS_WCKV + (size_t)2 * MEM_WIDTH * D_MODEL * 2;
constexpr size_t WS_WPOOL = WS_WCO  + (size_t)D_MODEL * MEM_WIDTH * 2;
constexpr size_t WS_H     = WS_WPOOL + (size_t)4 * 256 * 256 * 2;
constexpr size_t WS_MN    = WS_H    + (size_t)NTOK * D_MODEL * 2;
constexpr size_t WS_PROJ  = WS_MN   + (size_t)MEM_ROWS * D_MODEL * 2;
constexpr size_t WS_KVC   = WS_PROJ + (size_t)NTOK * IN_WIDTH * 2;
constexpr size_t WS_PBUF  = WS_KVC  + (size_t)MEM_ROWS * 1024 * 2;
constexpr size_t WS_POOL  = WS_PBUF + (size_t)NTOK * 1024 * 2;
constexpr size_t WS_ATTN  = WS_POOL + (size_t)NTOK * 1024 * 2;
constexpr size_t WS_SCR   = WS_ATTN + (size_t)NTOK * 1024 * 2;
constexpr size_t WS_MIXED = WS_SCR  + (size_t)NTOK * D_MODEL * 4;
constexpr size_t WS_X1    = WS_MIXED + (size_t)NTOK * D_MODEL * 2;
constexpr size_t WS_X1B   = WS_X1   + (size_t)NTOK * D_MODEL * 4;
constexpr size_t WS_SS1   = WS_X1B  + (size_t)NTOK * D_MODEL * 2;
constexpr size_t WS_QC    = WS_SS1  + (size_t)NTOK * 32 * 4;
constexpr size_t WS_OC    = WS_QC   + (size_t)NTOK * MEM_WIDTH * 2;
constexpr size_t WS_X2    = WS_OC   + (size_t)NTOK * MEM_WIDTH * 2;
constexpr size_t WS_TOKE  = WS_X2   + (size_t)NTOK * D_MODEL * 4;
constexpr size_t WS_TOKP  = WS_TOKE + (size_t)NTOK * 4 * 4;
constexpr size_t WS_TOKG  = WS_TOKP + (size_t)NTOK * 4 * 4;
constexpr size_t WS_LTOK  = WS_TOKG + (size_t)NTOK * 4 * 4;
constexpr size_t WS_LGATE = WS_LTOK + (size_t)N_EXPERTS * ECAP * 4;
constexpr size_t WS_ACT   = WS_LGATE + (size_t)N_EXPERTS * ECAP * 4;
constexpr size_t WS_YS    = WS_ACT  + (size_t)SLOT_ROWS * F8_PITCH;
constexpr size_t WS_WGU   = WS_YS   + (size_t)SLOT_ROWS * D_MODEL * 2;
constexpr size_t WS_WDN   = WS_WGU  + (size_t)N_EXPERTS * 4096 * 2048;
constexpr size_t WS_END   = WS_WDN  + (size_t)N_EXPERTS * 2048 * 2048;
constexpr int CW_BAR = 1024;
constexpr int CW_CNT = 8192;
static_assert((CW_CNT + 32 * 64) * 4 <= (int)CTL_ZERO_BYTES, "CTL words inside the memset region");
constexpr int RING_BYTES = 131072, MISC_OFF = RING_BYTES, TAB_OFF = RING_BYTES + 512;
constexpr int TAB_TSTART = TAB_OFF, TAB_CNT = TAB_OFF + 34 * 4, TAB_TILEE = TAB_CNT + 32 * 4, TAB_RSTD = TAB_TILEE + MAX_TILES * 4, TAB_END = TAB_RSTD + 256 * 4;
constexpr int LDS_BYTES = 147456;
static_assert(TAB_END <= LDS_BYTES, "LDS map");
constexpr int NWAVES = 8;

#define RLX_AGENT __ATOMIC_RELAXED, __HIP_MEMORY_SCOPE_AGENT
#define LDS_WAIT() asm volatile("s_waitcnt lgkmcnt(0)" ::: "memory")
#define XB_TMO      128
#define XB_XCNT(j)  (256  + 64 * (j))
#define XB_XSUB(j)  (1280 + 64 * (j))
#define XB_XGEN(j)  (2304 + 64 * (j))
#define XB_TOP      3328
#define XB_TOPGEN   3392
#define XCD_BAR_WORDS 3456
#define XB_SPIN_CAP (1u << 18)
__device__ __forceinline__ unsigned xb_ld(unsigned* p)              { return __hip_atomic_load(p, __ATOMIC_RELAXED, __HIP_MEMORY_SCOPE_AGENT); }
__device__ __forceinline__ unsigned xb_add(unsigned* p, unsigned v) { return __hip_atomic_fetch_add(p, v, __ATOMIC_RELAXED, __HIP_MEMORY_SCOPE_AGENT); }
__device__ __forceinline__ unsigned xb_xcc_id() { return (unsigned)__builtin_amdgcn_s_getreg((3 << 11) | 20) & 0xFu; }
#define XB_SPIN(cond, bar) do { unsigned _sp = 0; while (cond) { __builtin_amdgcn_s_sleep(1); \
    if ((++_sp & 255u) == 0u) { if (xb_ld(&(bar)[XB_TMO])) break; if (_sp > XB_SPIN_CAP) { atomicAdd(&(bar)[XB_TMO], 1u); break; } } } } while (0)
struct XcdBarrier { unsigned* bar; unsigned x; volatile LAS unsigned* st; };
__device__ __forceinline__ XcdBarrier xcd_barrier_post(unsigned* bar, volatile LAS unsigned* st) {
    XcdBarrier b; b.bar = bar; b.x = xb_xcc_id(); b.st = st;
    if (threadIdx.x == 0) (void)xb_add(&bar[XB_XCNT(b.x)], 1u);
    return b;
}
__device__ __forceinline__ void xcd_barrier_complete(unsigned* bar, unsigned x, unsigned& nloc, unsigned& nx) {
    const unsigned G = gridDim.x * gridDim.y * gridDim.z;
    unsigned sum, cnt, mine, sp = 0u;
    for (;;) {
        sum = 0u; cnt = 0u; mine = 0u;
#pragma unroll
        for (unsigned j = 0; j < 16; ++j) { const unsigned c = xb_ld(&bar[XB_XCNT(j)]); sum += c; cnt += (c > 0u) ? 1u : 0u; mine = (j == x) ? c : mine; }
        if (sum == G) break;
        __builtin_amdgcn_s_sleep(1);
        if ((++sp & 255u) == 0u) { if (xb_ld(&bar[XB_TMO])) break; if (sp > XB_SPIN_CAP) { atomicAdd(&bar[XB_TMO], 1u); break; } }
    }
    nloc = mine > 0u ? mine : 1u; nx = cnt > 0u ? cnt : 1u;
}
__device__ __forceinline__ void xcd_barrier(const XcdBarrier& b) {
    asm volatile("s_waitcnt vmcnt(0)" ::: "memory");
    __syncthreads();
    if (threadIdx.x == 0) {
        unsigned* bar = b.bar;
        __builtin_amdgcn_s_waitcnt(0);
        unsigned nloc = b.st[0], nx = b.st[1];
        if (nloc == 0u) { xcd_barrier_complete(bar, b.x, nloc, nx); b.st[0] = nloc; b.st[1] = nx; }
        const unsigned old = xb_add(&bar[XB_XSUB(b.x)], 1u);
        const unsigned gen = old / nloc;
        if (old + 1u == (gen + 1u) * nloc) {
            __builtin_amdgcn_fence(__ATOMIC_RELEASE, "agent");
            asm volatile("s_waitcnt vmcnt(0)" ::: "memory");
            const unsigned og = xb_add(&bar[XB_TOP], 1u);
            const unsigned tg = og / nx;
            if (og + 1u == (tg + 1u) * nx) xb_add(&bar[XB_TOPGEN], 1u);
            else XB_SPIN(xb_ld(&bar[XB_TOPGEN]) == tg, bar);
            __builtin_amdgcn_fence(__ATOMIC_ACQUIRE, "agent");
            xb_add(&bar[XB_XGEN(b.x)], 1u);
            asm volatile("s_waitcnt vmcnt(0)" ::: "memory");
        } else {
            XB_SPIN(xb_ld(&bar[XB_XGEN(b.x)]) == gen, bar);
            __builtin_amdgcn_fence(__ATOMIC_ACQUIRE, "agent");
            asm volatile("s_waitcnt vmcnt(0)" ::: "memory");
        }
    }
    __syncthreads();
}

__device__ __forceinline__ float wave_sum(float v) {
#pragma unroll
    for (int o = 1; o < 64; o <<= 1) v += __shfl_xor(v, o);
    return v;
}
__device__ __forceinline__ void rms_row_bf16(const float* xrow, const float* g, bf16_t* orow, int lane) {
    const f32x4* xr = (const f32x4*)xrow + lane; const f32x4* gr = (const f32x4*)g + lane;
    f32x4 v[8]; float s = 0.f;
#pragma unroll
    for (int j = 0; j < 8; ++j) { v[j] = xr[64 * j]; s += (v[j][0] * v[j][0] + v[j][1] * v[j][1]) + (v[j][2] * v[j][2] + v[j][3] * v[j][3]); }
    const float rstd = rsqrtf(wave_sum(s) * (1.f / D_MODEL) + NORM_EPS);
    u32x2* o8 = (u32x2*)orow + lane;
#pragma unroll
    for (int j = 0; j < 8; ++j) { const f32x4 w = v[j] * rstd * gr[64 * j]; u32x2 o; o.x = cvt_pk_bf16(w[0], w[1]); o.y = cvt_pk_bf16(w[2], w[3]); o8[64 * j] = o; }
}
__device__ __forceinline__ void cvt_store_lines(LAS unsigned char* buf, const u32x4 (&pc)[4], unsigned char* WTblk  , size_t pitchB, int wave, int lane) {
#pragma unroll
    for (int j = 0; j < 4; ++j) { const int n = 4 * lane + j; *(LAS u32x4*)(buf + n * 128 + (((wave + (n >> 2)) & 7) << 4)) = pc[j]; }
    asm volatile("s_waitcnt lgkmcnt(0)" ::: "memory"); __builtin_amdgcn_s_barrier(); asm volatile("" ::: "memory");
#pragma unroll
    for (int i = 0; i < 4; ++i) { const int row = 32 * wave + 8 * i + (lane >> 3), c = lane & 7; const u32x4 w = *(const LAS u32x4*)(buf + row * 128 + (((c + (row >> 2)) & 7) << 4));
        __builtin_nontemporal_store(w, (u32x4*)(WTblk + (size_t)row * pitchB + 16 * c)); }
}
__device__ __forceinline__ void cvt_blk_bf16(LAS unsigned char* buf, const float* W, int K, int N, bf16_t* WT, const float* kscale, int blk, int wave, int lane) {
    const int nblk = N / 256, kb = blk / nblk, nb = blk % nblk, k0 = 64 * kb + 8 * wave, n0 = 256 * nb + 4 * lane;
    const float* src = W + (size_t)k0 * N + n0; f32x4 v[8];
#pragma unroll
    for (int r = 0; r < 8; ++r) v[r] = __builtin_nontemporal_load((const f32x4*)(src + (size_t)r * N));
    if (kscale) { const f32x4 s0 = *(const f32x4*)(kscale + k0), s1 = *(const f32x4*)(kscale + k0 + 4);
#pragma unroll
        for (int r = 0; r < 4; ++r) { v[r] = v[r] * s0[r]; v[4 + r] = v[4 + r] * s1[r]; } }
    u32x4 pc[4];
#pragma unroll
    for (int j = 0; j < 4; ++j) { pc[j].x = cvt_pk_bf16(v[0][j], v[1][j]); pc[j].y = cvt_pk_bf16(v[2][j], v[3][j]); pc[j].z = cvt_pk_bf16(v[4][j], v[5][j]); pc[j].w = cvt_pk_bf16(v[6][j], v[7][j]); }
    cvt_store_lines(buf, pc, (unsigned char*)(WT + (size_t)(256 * nb) * K + 64 * kb), (size_t)K * 2, wave, lane);
}
__device__ __forceinline__ void cvt_blk_fp8(LAS unsigned char* buf, const float* W, int K, int N, unsigned char* WT, int blk, int wave, int lane) {
    const int nblk = N / 256, kb = blk / nblk, nb = blk % nblk, k0 = 128 * kb + 16 * wave, n0 = 256 * nb + 4 * lane;
    const float* src = W + (size_t)k0 * N + n0; f32x4 v[16];
#pragma unroll
    for (int r = 0; r < 16; ++r) v[r] = __builtin_nontemporal_load((const f32x4*)(src + (size_t)r * N)) * W_FP8_MUL;
    u32x4 pc[4];
#pragma unroll
    for (int j = 0; j < 4; ++j) { pc[j].x = pack4_fp8(v[0][j], v[1][j], v[2][j], v[3][j]); pc[j].y = pack4_fp8(v[4][j], v[5][j], v[6][j], v[7][j]); pc[j].z = pack4_fp8(v[8][j], v[9][j], v[10][j], v[11][j]); pc[j].w = pack4_fp8(v[12][j], v[13][j], v[14][j], v[15][j]); }
    cvt_store_lines(buf, pc, WT + ((size_t)nb * (K / 128) + kb) * 32768, (size_t)128, wave, lane);
}
constexpr int CVT_I_GU = 16 * 16, CVT_I_DN = 16 * 8, CVT_NMOE = N_EXPERTS * (CVT_I_GU + CVT_I_DN);
__device__ __forceinline__ void cvt_moe_block(LAS unsigned char* buf, const float* w_gu, const float* w_dn, unsigned char* Wt_gu, unsigned char* Wt_dn, int it, int wave, int lane) {
    if (it < N_EXPERTS * CVT_I_GU) { const int e = it / CVT_I_GU; cvt_blk_fp8(buf, w_gu + (size_t)e * 2048 * 4096, 2048, 4096, Wt_gu + (size_t)e * 4096 * 2048, it % CVT_I_GU, wave, lane); }
    else { const int r = it - N_EXPERTS * CVT_I_GU, e = r / CVT_I_DN; cvt_blk_fp8(buf, w_dn + (size_t)e * 2048 * 2048, 2048, 2048, Wt_dn + (size_t)e * 2048 * 2048, r % CVT_I_DN, wave, lane); }
}
constexpr int DEF1_W0 = 128, DEF1_N = 68, DEF1_B0 = 0,                              DEF1_CNT = (256 - DEF1_W0) * DEF1_N;
constexpr int DEF6_W0 = 64, DEF6_N = 15, DEF6_B0 = DEF1_B0 + DEF1_CNT,             DEF6_CNT = (256 - DEF6_W0) * DEF6_N;
constexpr int DEF7_W0 = 128, DEF7_N = 0, DEF7_B0 = DEF6_B0 + DEF6_CNT,            DEF7_CNT = (256 - DEF7_W0) * DEF7_N;
constexpr int DEF3_W0 = 128, DEF3_N = 2, DEF3_B0 = DEF7_B0 + DEF7_CNT,            DEF3_CNT = (256 - DEF3_W0) * DEF3_N;
constexpr int DEF1S_W0 = 72, DEF1S_N = 8, DEF1S_B0 = DEF3_B0 + DEF3_CNT, DEF1S_CNT = (DEF1_W0 - DEF1S_W0) * DEF1S_N;
constexpr int DEF_TOTAL = DEF1S_B0 + DEF1S_CNT;
static_assert(DEF_TOTAL <= CVT_NMOE, "deferred MoE blocks");
#define CVT_DEFERRED(W0, N, B0) do { if (G == 256 && bx >= (W0)) { _Pragma("unroll 1") for (int _j = 0; _j < (N); ++_j) \
        cvt_moe_block(lds + (_j & 1) * 32768, args.in[20], args.in[22], Wt_gu, Wt_dn, (B0) + (bx - (W0)) + (256 - (W0)) * _j, wave, lane); __syncthreads(); } } while (0)
__device__ __forceinline__ MoeTab build_moe_tables(LAS unsigned char* lds, unsigned* ctl) {
    LAS int* tstart = (LAS int*)(lds + TAB_TSTART); LAS int* cnt = (LAS int*)(lds + TAB_CNT); LAS int* tile_e = (LAS int*)(lds + TAB_TILEE);
    if (threadIdx.x < 64) {
        const int e = threadIdx.x & 31; const int c = (int)__hip_atomic_load(ctl + CW_CNT + 64 * e, RLX_AGENT); const int nt = (c + 255) >> 8;
        int incl = nt;
#pragma unroll
        for (int o = 1; o < 32; o <<= 1) { const int t = __shfl_up(incl, o, 64); if (e >= o) incl += t; }
        const int excl = incl - nt;
        if (threadIdx.x < 32) { cnt[e] = c; tstart[e] = excl; if (e == 31) tstart[32] = incl; for (int j = 0; j < nt; ++j) tile_e[excl + j] = e; }
    }
    __syncthreads();
    MoeTab T; T.tstart = tstart; T.cnt = cnt; T.tile_e = tile_e; return T;
}

struct Args { const float* in[25]; float* out; unsigned char* ws; int ph_lo, ph_hi, probe, pad; };
static_assert(sizeof(Args) == 27 * 8 + 16, "Args has no padding");
constexpr int N_PHASES = 13;

__global__ void __launch_bounds__(NWAVES * 64, 2) mk_fwd(Args args) {
    extern __shared__ __attribute__((aligned(16))) unsigned char lds_g[];
    LAS unsigned char* lds = (LAS unsigned char*)lds_g;
    volatile LAS unsigned* MISC = (volatile LAS unsigned*)(lds + MISC_OFF);
    const int tid = threadIdx.x, lane = tid & 63, wave = __builtin_amdgcn_readfirstlane(tid >> 6);
    const int G = gridDim.x, bx = blockIdx.x; const int vcu = (G % 8 == 0) ? (bx % 8) * (G / 8) + bx / 8 : bx;
    const int gw = vcu * NWAVES + wave, NGW = G * NWAVES;
    unsigned char* ws = args.ws; unsigned* ctl = (unsigned*)(ws + WS_CTL);
    const int lo = args.ph_lo, hi = args.ph_hi;
    for (int u = tid; u < (LDS_BYTES - MISC_OFF) / 4; u += NWAVES * 64) ((LAS unsigned*)(lds + MISC_OFF))[u] = 0u;
    __syncthreads();
    XcdBarrier bar; bar.bar = ctl + CW_BAR; bar.x = 0; bar.st = nullptr;
    if (hi - lo > 1) bar = xcd_barrier_post(ctl + CW_BAR, MISC + 8);
#define IN(k) (lo <= (k) && (k) < hi)
#define SEAM(k) do { if (IN(k) && IN((k) + 1)) xcd_barrier(bar); } while (0)
    const float* x = args.in[0]; const float* mem = args.in[1];
    bf16_t* Wt_in = (bf16_t*)(ws + WS_WIN); bf16_t* Wt_au = (bf16_t*)(ws + WS_WAU); bf16_t* Wt_pu = (bf16_t*)(ws + WS_WPU); bf16_t* Wt_mo = (bf16_t*)(ws + WS_WMO);
    bf16_t* Wt_cq = (bf16_t*)(ws + WS_WCQ); bf16_t* Wt_ckv = (bf16_t*)(ws + WS_WCKV); bf16_t* Wt_co = (bf16_t*)(ws + WS_WCO); bf16_t* Wt_pool = (bf16_t*)(ws + WS_WPOOL);
    unsigned char* Wt_gu = ws + WS_WGU; unsigned char* Wt_dn = ws + WS_WDN;
    bf16_t* hbuf = (bf16_t*)(ws + WS_H); bf16_t* mnb = (bf16_t*)(ws + WS_MN); bf16_t* proj = (bf16_t*)(ws + WS_PROJ); bf16_t* kvc = (bf16_t*)(ws + WS_KVC);
    bf16_t* pbuf = (bf16_t*)(ws + WS_PBUF); bf16_t* poolb = (bf16_t*)(ws + WS_POOL); bf16_t* attnb = (bf16_t*)(ws + WS_ATTN); bf16_t* scratch = (bf16_t*)(ws + WS_SCR);
    bf16_t* mixed = (bf16_t*)(ws + WS_MIXED); bf16_t* x1b = (bf16_t*)(ws + WS_X1B); float* ss1 = (float*)(ws + WS_SS1);
    bf16_t* qc = (bf16_t*)(ws + WS_QC); bf16_t* oc = (bf16_t*)(ws + WS_OC); bf16_t* x2b = (bf16_t*)(ws + WS_X2);
    int* tok_e = (int*)(ws + WS_TOKE); int* tok_pos = (int*)(ws + WS_TOKP); float* tok_gate = (float*)(ws + WS_TOKG); int* list_tok = (int*)(ws + WS_LTOK); float* list_gate = (float*)(ws + WS_LGATE);
    unsigned char* act = ws + WS_ACT; unsigned char* ys = ws + WS_YS; unsigned char* h3f = ws + WS_H;

    if (IN(0)) {
        constexpr int I_IN = 32 * 26, I_UP = 16 * 8, I_MO = 32 * 8, I_C = 32 * 2, I_CO = 8 * 8, I_PW = 4 * 1, I_GU = 16 * 16, I_DN = 16 * 8;
        constexpr int NDENSE = I_IN + 2 * I_UP + I_MO + 3 * I_C + I_CO + 4 * I_PW, NMOE = N_EXPERTS * (I_GU + I_DN);
        for (int m = gw; m < NTOK; m += NGW) rms_row_bf16(x + (size_t)m * D_MODEL, args.in[2], hbuf + (size_t)m * D_MODEL, lane);
        for (int m = gw; m < MEM_ROWS; m += NGW) rms_row_bf16(mem + (size_t)m * D_MODEL, args.in[12], mnb + (size_t)m * D_MODEL, lane);
        int pp = 0;
        for (int it = vcu; it < NDENSE; it += G, pp ^= 1) { LAS unsigned char* buf = lds + pp * 32768;
            int r = it;
            if (r < I_IN) { cvt_blk_bf16(buf, args.in[3], 2048, IN_WIDTH, Wt_in, nullptr, r, wave, lane); continue; } r -= I_IN;
            if (r < I_UP) { cvt_blk_bf16(buf, args.in[8], 1024, 2048, Wt_au, nullptr, r, wave, lane); continue; } r -= I_UP;
            if (r < I_UP) { cvt_blk_bf16(buf, args.in[9], 1024, 2048, Wt_pu, nullptr, r, wave, lane); continue; } r -= I_UP;
            if (r < I_MO) { cvt_blk_bf16(buf, args.in[10], 2048, 2048, Wt_mo, nullptr, r, wave, lane); continue; } r -= I_MO;
            if (r < I_C)  { cvt_blk_bf16(buf, args.in[13], 2048, 512, Wt_cq, args.in[11], r, wave, lane); continue; } r -= I_C;
            if (r < I_C)  { cvt_blk_bf16(buf, args.in[14], 2048, 512, Wt_ckv, nullptr, r, wave, lane); continue; } r -= I_C;
            if (r < I_C)  { cvt_blk_bf16(buf, args.in[15], 2048, 512, Wt_ckv + (size_t)512 * 2048, nullptr, r, wave, lane); continue; } r -= I_C;
            if (r < I_CO) { cvt_blk_bf16(buf, args.in[16], 512, 2048, Wt_co, nullptr, r, wave, lane); continue; } r -= I_CO;
            { const int g = r / I_PW; cvt_blk_bf16(buf, args.in[6] + (size_t)g * 65536, 256, 256, Wt_pool + (size_t)g * 65536, nullptr, r % I_PW, wave, lane); }
        }
        for (int it = (G == 256 ? DEF_TOTAL : 0) + vcu; it < NMOE; it += G, pp ^= 1) cvt_moe_block(lds + pp * 32768, args.in[20], args.in[22], Wt_gu, Wt_dn, it, wave, lane);
        __syncthreads();
    }
    SEAM(0);
#ifdef MK_PROBE_P1
    if (IN(1) && args.probe == 1) {
        ProjSched S{(const char*)hbuf, (const char*)Wt_in, (const char*)mnb, (const char*)Wt_ckv, G, bx};
        EpiProj E{proj, kvc};
        pg8::gemm_phase<EpiProj, ProjSched, true, true>(lds, 2048, 2048, MK_PROBE_P1, S, E);
    }
#endif
    if (IN(1) && args.probe == 0) {
        const bool split = (G == 256);
        if (!split || bx < DEF1_W0) {
            ProjSched S{(const char*)hbuf, (const char*)Wt_in, (const char*)mnb, (const char*)Wt_ckv, split ? DEF1_W0 : G, bx};
            EpiProj E{proj, kvc};
            pg8::gemm_phase<EpiProj, ProjSched, true, true>(lds, 2048, 2048, 2048, S, E);
        }
        CVT_DEFERRED(DEF1_W0, DEF1_N, DEF1_B0);
        if (split && bx >= DEF1S_W0 && bx < DEF1_W0) {
#pragma unroll 1
            for (int j = 0; j < DEF1S_N; ++j) cvt_moe_block(lds + (j & 1) * 32768, args.in[20], args.in[22], Wt_gu, Wt_dn, DEF1S_B0 + (bx - DEF1S_W0) + (DEF1_W0 - DEF1S_W0) * j, wave, lane);
            __syncthreads(); }
    }
    SEAM(1);
    if (IN(2)) {
        LAS f32x2* cs = (LAS f32x2*)lds;
        for (int e = tid; e < 64 * 32; e += NWAVES * 64) { const int pos = e >> 5, i5 = e & 31; const float inv = exp2f(-(float)(2 * i5) * (13.287712379549449f / 64.f)); float sn, cn; sincosf((float)pos * inv, &sn, &cn); cs[e] = (f32x2){cn, sn}; }
        __syncthreads();
        { const float* qg = args.in[4]; const float* kg = args.in[5]; const int l16 = lane & 15;
          float gq[8], gk[8];
#pragma unroll
          for (int j = 0; j < 8; ++j) { gq[j] = qg[8 * l16 + j]; gk[j] = kg[8 * l16 + j]; }
          const bool first = (lane & 4) == 0, colang = (lane & 8) != 0;
          for (int task = gw; task < NTOK / 4; task += NGW) {
            u32x4 v[4][3];
#pragma unroll
            for (int tk = 0; tk < 4; ++tk)
#pragma unroll
                for (int g = 0; g < 3; ++g) { const int head = 4 * g + (lane >> 4); v[tk][g] = (u32x4){0u, 0u, 0u, 0u}; if (head < 10) v[tk][g] = *(const u32x4*)(proj + (size_t)(task * 4 + tk) * IN_WIDTH + head * 128 + 8 * l16); }
#pragma unroll
            for (int tk = 0; tk < 4; ++tk) { const int tok = task * 4 + tk, t = tok % SEQ, pos = colang ? (t & 63) : (t >> 6);
                const LAS f32x4* cp = (const LAS f32x4*)(cs + pos * 32 + 8 * (lane & 3)); const f32x4 c0 = cp[0], c1 = cp[1], c2 = cp[2], c3 = cp[3];
                const float cv[8] = {c0[0], c0[2], c1[0], c1[2], c2[0], c2[2], c3[0], c3[2]}, sv[8] = {c0[1], c0[3], c1[1], c1[3], c2[1], c2[3], c3[1], c3[3]};
#pragma unroll
                for (int g = 0; g < 3; ++g) { const int head = 4 * g + (lane >> 4); const u32x4 w = v[tk][g];
                    float xv[8] = {bf_lo(w.x), bf_hi(w.x), bf_lo(w.y), bf_hi(w.y), bf_lo(w.z), bf_hi(w.z), bf_lo(w.w), bf_hi(w.w)}; float ss = 0.f;
#pragma unroll
                    for (int j = 0; j < 8; ++j) ss += xv[j] * xv[j];
                    ss += __shfl_xor(ss, 1); ss += __shfl_xor(ss, 2); ss += __shfl_xor(ss, 4); ss += __shfl_xor(ss, 8);
                    const float rs = rsqrtf(ss * (1.f / 128.f) + NORM_EPS); float ov[8];
#pragma unroll
                    for (int j = 0; j < 8; ++j) { xv[j] = xv[j] * rs * (g < 2 ? gq[j] : gk[j]); const float pj = __shfl_xor(xv[j], 4); ov[j] = first ? (xv[j] * cv[j] - pj * sv[j]) : (xv[j] * cv[j] + pj * sv[j]); }
                    u32x4 o; o.x = cvt_pk_bf16(ov[0], ov[1]); o.y = cvt_pk_bf16(ov[2], ov[3]); o.z = cvt_pk_bf16(ov[4], ov[5]); o.w = cvt_pk_bf16(ov[6], ov[7]);
                    if (head < 10) *(u32x4*)(proj + (size_t)tok * IN_WIDTH + head * 128 + 8 * l16) = o; } }
          } }
        for (int task = gw; task < NTOK / 4; task += NGW) {
            const int tg = task >> 1, half = task & 1, tok0 = tg * 8, t0 = tok0 % SEQ, b = tok0 / SEQ, w2 = 1 << (2 * half + (lane >> 5));
            const bf16_t* ubase = proj + (size_t)b * SEQ * IN_WIDTH + V_END + 512 * half + 8 * lane;
            float md[16];
#pragma unroll
            for (int i = 0; i < 16; ++i) md[i] = (i - 8 >= -w2 && i - 8 < w2) ? 1.f : 0.f;
            float acc[8][8]; u32x4 ctr[8];
#pragma unroll
            for (int j = 0; j < 8; ++j)
#pragma unroll
                for (int c = 0; c < 8; ++c) acc[j][c] = 0.f;
            u32x4 rows[23];
#pragma unroll
            for (int r = 0; r < 23; ++r) { const int tt = t0 - 8 + r; rows[r] = (u32x4){0u, 0u, 0u, 0u}; if (tt >= 0 && tt < SEQ) rows[r] = *(const u32x4*)(ubase + (size_t)tt * IN_WIDTH); }
#pragma unroll
            for (int r = 0; r < 23; ++r) { const u32x4 w = rows[r]; const float val[8] = {bf_lo(w.x), bf_hi(w.x), bf_lo(w.y), bf_hi(w.y), bf_lo(w.z), bf_hi(w.z), bf_lo(w.w), bf_hi(w.w)};
                if (r >= 8 && r < 16) ctr[r - 8] = w;
#pragma unroll
                for (int j = 0; j < 8; ++j) { if (r - j >= 0 && r - j < 16) { const float m = md[r - j];
#pragma unroll
                    for (int c = 0; c < 8; ++c) acc[j][c] = fmaf(m, val[c], acc[j][c]); } } }
#pragma unroll
            for (int j = 0; j < 8; ++j) { const int t = t0 + j; int wlo = t - w2; if (wlo < 0) wlo = 0; int whi = t + w2; if (whi > SEQ) whi = SEQ; const float rc = 1.f / (float)(whi - wlo); const u32x4 w = ctr[j];
                u32x4 o; o.x = cvt_pk_bf16(acc[j][0] * rc - bf_lo(w.x), acc[j][1] * rc - bf_hi(w.x)); o.y = cvt_pk_bf16(acc[j][2] * rc - bf_lo(w.y), acc[j][3] * rc - bf_hi(w.y));
                o.z = cvt_pk_bf16(acc[j][4] * rc - bf_lo(w.z), acc[j][5] * rc - bf_hi(w.z)); o.w = cvt_pk_bf16(acc[j][6] * rc - bf_lo(w.w), acc[j][7] * rc - bf_hi(w.w));
                *(u32x4*)(pbuf + (size_t)(tok0 + j) * 1024 + 512 * half + 8 * lane) = o; }
        }
        __syncthreads();
    }
    SEAM(2);
    if (IN(3)) {
        for (int u = bx; u < 256; u += G) { const int combo = (u & 7) >> 1, b = combo >> 1, kvh = combo & 1, idx = ((u >> 3) << 1) | (u & 1), h = kvh * 4 + (idx >> 4), qb = idx & 15;
            const bf16_t* Qb = proj + ((size_t)b * SEQ + qb * 256) * IN_WIDTH + h * 128; const bf16_t* Kh = proj + (size_t)b * SEQ * IN_WIDTH + Q_END + kvh * 128; const bf16_t* Vh = proj + (size_t)b * SEQ * IN_WIDTH + K_END + kvh * 128;
            attn::attn_dense_body<IN_WIDTH, IN_WIDTH, ATTN_WIDTH>(Qb, Kh, Vh, attnb + ((size_t)b * SEQ + qb * 256) * ATTN_WIDTH + h * 128, SEQ, (char*)lds_g); }
        PoolSched S{(const char*)pbuf, (const char*)Wt_pool, G, bx};
        EpiBf16<1> E{poolb, 1024, 256, args.in[7], nullptr};
        pg8::gemm_phase<EpiBf16<1>, PoolSched, false, true>(lds, 1024, 256, 256, S, E);
        CVT_DEFERRED(DEF3_W0, DEF3_N, DEF3_B0);
    }
    SEAM(3);
    if (IN(4)) {
        MixSched S{(const char*)attnb, (const char*)Wt_au, (const char*)poolb, (const char*)Wt_pu, G, bx};
        EpiMix E{proj, scratch, mixed};
        pg8::gemm_phase<EpiMix, MixSched, false, true>(lds, 1024, 1024, 1024, S, E);
    }
    SEAM(4);
    if (IN(5)) {
        DenseSched S{(const char*)mixed, (const char*)Wt_mo, 2048, 2048, 32, 8, G, bx};
        EpiResid<false, true> E{x, x1b, ss1};
        pg8::gemm_phase<EpiResid<false, true>, DenseSched, false, true>(lds, 2048, 2048, 2048, S, E);
    }
    SEAM(5);
    if (IN(6)) {
        if (bx < 64 && G >= 64) {
            int pm, pn; pg8::tile_order(bx, 32, 2, pm, pn); LAS float* rt = (LAS float*)(lds + TAB_RSTD);
            const int row = tid >> 1, hf = tid & 1; const float* sp = ss1 + (size_t)(pm * 256 + row) * 32 + hf * 16; float s = 0.f;
#pragma unroll
            for (int j = 0; j < 4; ++j) { const f32x4 v = *(const f32x4*)(sp + 4 * j); s += (v[0] + v[1]) + (v[2] + v[3]); }
            s += __shfl_xor(s, 1); if (hf == 0) rt[row] = rsqrtf(s * (1.f / D_MODEL) + NORM_EPS);
        }
        __syncthreads();
        DenseSched S{(const char*)x1b, (const char*)Wt_cq, 2048, 2048, 32, 2, G, bx};
        EpiBf16<2> E{qc, 512, 256, nullptr, (const LAS float*)(lds + TAB_RSTD)};
        pg8::gemm_phase<EpiBf16<2>, DenseSched, false, true>(lds, 2048, 2048, 2048, S, E);
        if (bx < 64 && G >= 64) {
            asm volatile("s_waitcnt vmcnt(0)" ::: "memory"); __syncthreads();
            __builtin_amdgcn_fence(__ATOMIC_ACQUIRE, "agent"); asm volatile("s_waitcnt vmcnt(0)" ::: "memory"); __syncthreads();
            int pm, pn; pg8::tile_order(bx, 32, 2, pm, pn); const int b = pm >> 4, qb = pm & 15;
#pragma unroll 1
            for (int hh = 0; hh < 2; ++hh) { const int h = 2 * pn + hh;
                attn::attn_dense_body<MEM_WIDTH, 1024, MEM_WIDTH>(qc + ((size_t)b * SEQ + qb * 256) * MEM_WIDTH + h * 128, kvc + (size_t)b * MEM_LEN * 1024 + h * 128, kvc + (size_t)b * MEM_LEN * 1024 + 512 + h * 128,
                                                               oc + ((size_t)b * SEQ + qb * 256) * MEM_WIDTH + h * 128, MEM_LEN, (char*)lds_g); }
        }
        CVT_DEFERRED(DEF6_W0, DEF6_N, DEF6_B0);
    }
    SEAM(7);
    if (IN(8)) {
        DenseSched S{(const char*)oc, (const char*)Wt_co, 512, 512, 32, 8, G, bx};
        EpiResid<true, false> E{x1b, x2b, nullptr};
        pg8::gemm_phase<EpiResid<true, false>, DenseSched, false, true>(lds, 512, 512, 512, S, E);
    }
    SEAM(8);
    if (IN(9)) {
        const float* gm = args.in[17]; const float* wrt = args.in[18]; const float* brt = args.in[19];
        LAS float* part = (LAS float*)lds;
        LAS float* ssqp = (LAS float*)(lds + 8 * 32 * 33 * 4);
        LAS float* lg = ssqp + 256;
        LAS float* rs_l = lg + 32 * 33;
        LAS int* tsel = (LAS int*)(rs_l + 32);
        LAS float* tgt = (LAS float*)(tsel + 128);
        LAS int* lrank = (LAS int*)(tgt + 128);
        LAS int* hist = lrank + 128;
        LAS int* ebase = hist + 32;
        for (int tt = vcu; tt < NTOK / 32; tt += G) {
            const int tok0 = tt * 32, i = lane & 31, hh = lane >> 5, ks = 256 * wave;
            if (tid < 32) hist[tid] = 0;
            const bf16_t* xr = x2b + (size_t)(tok0 + i) * D_MODEL + ks + 4 * hh; const float* wp = wrt + (size_t)(ks + 4 * hh) * 32 + i; const float* gp = gm + ks + 4 * hh;
            f32x16 acc = {}; float ssq = 0.f;
#pragma unroll 4
            for (int q = 0; q < 32; ++q) { const u32x2 ab = *(const u32x2*)(xr + 8 * q); const f32x4 a = {bf_lo(ab.x), bf_hi(ab.x), bf_lo(ab.y), bf_hi(ab.y)}; const f32x4 gg = *(const f32x4*)(gp + 8 * q);
                const float b0 = wp[(8 * q + 0) * 32], b1 = wp[(8 * q + 1) * 32], b2 = wp[(8 * q + 2) * 32], b3 = wp[(8 * q + 3) * 32];
                ssq += (a[0] * a[0] + a[1] * a[1]) + (a[2] * a[2] + a[3] * a[3]);
                acc = __builtin_amdgcn_mfma_f32_32x32x2f32(a[0], b0 * gg[0], acc, 0, 0, 0); acc = __builtin_amdgcn_mfma_f32_32x32x2f32(a[1], b1 * gg[1], acc, 0, 0, 0);
                acc = __builtin_amdgcn_mfma_f32_32x32x2f32(a[2], b2 * gg[2], acc, 0, 0, 0); acc = __builtin_amdgcn_mfma_f32_32x32x2f32(a[3], b3 * gg[3], acc, 0, 0, 0); }
            ssq += __shfl_xor(ssq, 32);
            if (lane < 32) ssqp[wave * 32 + lane] = ssq;
#pragma unroll
            for (int r = 0; r < 16; ++r) { const int trow = (r & 3) + 8 * (r >> 2) + 4 * hh; part[(wave * 32 + trow) * 33 + i] = acc[r]; }
            __syncthreads();
            { const int tk = tid >> 4, eg = tid & 15; float s2 = 0.f, l0 = 0.f, l1 = 0.f;
#pragma unroll
              for (int w = 0; w < 8; ++w) { s2 += ssqp[w * 32 + tk]; l0 += part[(w * 32 + tk) * 33 + 2 * eg]; l1 += part[(w * 32 + tk) * 33 + 2 * eg + 1]; }
              const float rstd = rsqrtf(s2 * (1.f / D_MODEL) + NORM_EPS);
              lg[tk * 33 + 2 * eg] = l0 * rstd + brt[2 * eg]; lg[tk * 33 + 2 * eg + 1] = l1 * rstd + brt[2 * eg + 1]; if (eg == 0) rs_l[tk] = rstd; }
            __syncthreads();
            if (tid < 32) { float v[32];
#pragma unroll
                for (int e = 0; e < 32; ++e) v[e] = lg[tid * 33 + e];
                int sel[4]; float val[4];
#pragma unroll
                for (int k = 0; k < 4; ++k) { int bi = 0; float bv = -INFINITY;
#pragma unroll
                    for (int e = 0; e < 32; ++e) { const bool better = v[e] > bv; bv = better ? v[e] : bv; bi = better ? e : bi; }
                    sel[k] = bi; val[k] = bv;
#pragma unroll
                    for (int e = 0; e < 32; ++e) v[e] = (e == bi) ? -INFINITY : v[e]; }
                float ex[4], den = 0.f;
#pragma unroll
                for (int k = 0; k < 4; ++k) { ex[k] = __expf(val[k] - val[0]); den += ex[k]; }
                const float rden = 1.f / den;
#pragma unroll
                for (int k = 0; k < 4; ++k) { tsel[tid * 4 + k] = sel[k]; tgt[tid * 4 + k] = ex[k] * rden; lrank[tid * 4 + k] = __hip_atomic_fetch_add((int*)(hist + sel[k]), 1, __ATOMIC_RELAXED, __HIP_MEMORY_SCOPE_WORKGROUP); } }
            __syncthreads();
            if (tid < 32) { const int hc = hist[tid]; int bs = 0; if (hc > 0) bs = (int)__hip_atomic_fetch_add(ctl + CW_CNT + 64 * tid, (unsigned)hc, RLX_AGENT); ebase[tid] = bs; }
            __syncthreads();
            if (tid < 128) { const int tk = tid >> 2, k = tid & 3, e = tsel[tk * 4 + k], pos = ebase[e] + lrank[tk * 4 + k]; const float gt = tgt[tk * 4 + k]; const int tg = tok0 + tk;
                tok_e[tg * 4 + k] = e; tok_pos[tg * 4 + k] = pos; tok_gate[tg * 4 + k] = gt; list_tok[(size_t)e * ECAP + pos] = tg; list_gate[(size_t)e * ECAP + pos] = gt; }
#pragma unroll 1
            for (int j = 0; j < 4; ++j) { const int tk = wave * 4 + j; const float rstd = rs_l[tk];
                const u32x2* xr4 = (const u32x2*)(x2b + (size_t)(tok0 + tk) * D_MODEL) + lane; const f32x4* gr4 = (const f32x4*)gm + lane; unsigned* o4 = (unsigned*)(h3f + (size_t)(tok0 + tk) * F8_PITCH) + lane;
#pragma unroll
                for (int q = 0; q < 8; ++q) { const u32x2 xb = xr4[64 * q]; const f32x4 w = (f32x4){bf_lo(xb.x), bf_hi(xb.x), bf_lo(xb.y), bf_hi(xb.y)} * rstd * gr4[64 * q]; o4[64 * q] = pack4_fp8(w[0], w[1], w[2], w[3]); } }
            __syncthreads();
        }
    }
    SEAM(9);
#if defined(MK_PROBE_MOE) && (MK_PROBE_MOE & 15) == 9
    if (IN(10) && args.probe == 1) {
        DenseSched S{(const char*)h3f, (const char*)Wt_gu, F8_PITCH / 2, 1024, 32, 72, G, bx};
        EpiSwiglu E{args.in[21], act};
        pg8::gemm_phase<EpiSwiglu, DenseSched, true, true, true>(lds, F8_PITCH / 2, 1024, 1024, S, E);
    }
#elif defined(MK_PROBE_MOE)
    if (IN(10) && args.probe == 1) {
        const MoeTab T = build_moe_tables(lds, ctl);
        Moe1Sched S{(const char*)h3f, (const char*)Wt_gu, list_tok, T, G, bx, (MK_PROBE_MOE >> 4) & 15};
        EpiSwiglu E{args.in[21], act, (MK_PROBE_MOE >> 8)};
        pg8::gemm_phase<EpiSwiglu, Moe1Sched, true, true, ((MK_PROBE_MOE & 15) < 10), ((MK_PROBE_MOE & 15) % 10)>(lds, 1024, 64, ((MK_PROBE_MOE & 15) == 8 || (MK_PROBE_MOE & 15) == 11) ? 2048 : 1024, S, E, 32768);
    }
#endif
    if (IN(10) && args.probe == 0) {
        const MoeTab T = build_moe_tables(lds, ctl);
        Moe1Sched S{(const char*)h3f, (const char*)Wt_gu, list_tok, T, G, bx};
        EpiSwiglu E{args.in[21], act};
        pg8::gemm_phase<EpiSwiglu, Moe1Sched, true, true, true>(lds, 1024, 64, 1024, S, E, 32768);
    }
    SEAM(10);
    if (IN(11)) {
        const MoeTab T = build_moe_tables(lds, ctl);
        Moe2Sched S{(const char*)act, (const char*)Wt_dn, T, G, bx};
        EpiDown E{args.in[23], ys};
        pg8::gemm_phase<EpiDown, Moe2Sched, true, true, true>(lds, 1024, 64, 1024, S, E, 32768);
    }
    SEAM(11);
    if (IN(12)) {
        const MoeTab T = build_moe_tables(lds, ctl);
        const float* gfin = args.in[24];
        auto load_tok = [&](int tok, u32x4 (&xb)[2][2], u32x4 (&yb)[4][2], float (&gt)[4]) {
#pragma unroll
            for (int j = 0; j < 2; ++j) { const u32x4* xr = (const u32x4*)(x2b + (size_t)tok * D_MODEL + 1024 * j + 16 * lane); xb[j][0] = xr[0]; xb[j][1] = xr[1]; }
#pragma unroll
            for (int k = 0; k < 4; ++k) { const int e = tok_e[tok * 4 + k], pos = tok_pos[tok * 4 + k]; gt[k] = tok_gate[tok * 4 + k]; const unsigned char* yr = ys + (size_t)(T.tstart[e] * 256 + pos) * D_MODEL + 16 * lane;
                yb[k][0] = *(const u32x4*)yr; yb[k][1] = *(const u32x4*)(yr + 1024); } };
        auto finish_tok = [&](int tok, const u32x4 (&xb)[2][2], const u32x4 (&yb)[4][2], const float (&gt)[4]) {
            float v[2][16]; float s = 0.f;
#pragma unroll
            for (int j = 0; j < 2; ++j)
#pragma unroll
                for (int h = 0; h < 2; ++h) { const u32x4 w = xb[j][h]; const unsigned ww[4] = {w.x, w.y, w.z, w.w};
#pragma unroll
                    for (int q = 0; q < 4; ++q) { v[j][8 * h + 2 * q] = bf_lo(ww[q]); v[j][8 * h + 2 * q + 1] = bf_hi(ww[q]); } }
#pragma unroll
            for (int k = 0; k < 4; ++k)
#pragma unroll
                for (int j = 0; j < 2; ++j) { const u32x4 w = yb[k][j]; const unsigned ww[4] = {w.x, w.y, w.z, w.w};
#pragma unroll
                    for (int q = 0; q < 4; ++q) { const auto lo = __builtin_amdgcn_cvt_pk_f32_fp8((int)ww[q], false), hi = __builtin_amdgcn_cvt_pk_f32_fp8((int)ww[q], true);
                        v[j][4 * q] += gt[k] * lo[0]; v[j][4 * q + 1] += gt[k] * lo[1]; v[j][4 * q + 2] += gt[k] * hi[0]; v[j][4 * q + 3] += gt[k] * hi[1]; } }
#pragma unroll
            for (int j = 0; j < 2; ++j)
#pragma unroll
                for (int c = 0; c < 16; ++c) s += v[j][c] * v[j][c];
            const float rstd = rsqrtf(wave_sum(s) * (1.f / D_MODEL) + NORM_EPS);
#pragma unroll
            for (int j = 0; j < 2; ++j) { const f32x4* gp = (const f32x4*)(gfin + 1024 * j + 16 * lane); f32x4* op = (f32x4*)(args.out + (size_t)tok * D_MODEL + 1024 * j + 16 * lane);
#pragma unroll
                for (int q = 0; q < 4; ++q) op[q] = (f32x4){v[j][4 * q], v[j][4 * q + 1], v[j][4 * q + 2], v[j][4 * q + 3]} * rstd * gp[q]; } };
        for (int tok = gw; tok < NTOK; tok += 2 * NGW) {
            u32x4 xa[2][2], ya[4][2], xc[2][2], yc[4][2]; float ga[4], gc[4]; const int tok2 = tok + NGW; const bool two = tok2 < NTOK;
            load_tok(tok, xa, ya, ga); if (two) load_tok(tok2, xc, yc, gc);
            finish_tok(tok, xa, ya, ga); if (two) finish_tok(tok2, xc, yc, gc);
        }
    }
#undef IN
#undef SEAM
}

#ifndef MK_N_LAUNCHES
#define MK_N_LAUNCHES 1
#endif
extern "C" void kernel_launch(void* const* d_in, const int* in_sizes, int n_in, void* d_out, int out_size, void* d_ws, size_t ws_size, hipStream_t stream) {
    static int grid = 0;
    if (grid == 0) {
        if (n_in != 25 || out_size != NTOK * D_MODEL || ws_size < WS_END) { fprintf(stderr, "kernel_launch: shape/workspace mismatch (n_in %d out %d ws %zu need %zu)\n", n_in, out_size, ws_size, (size_t)WS_END); grid = -1; return; }
        int dev = 0, cus = 0, per_cu = 0;
        if (hipGetDevice(&dev) != hipSuccess || hipDeviceGetAttribute(&cus, hipDeviceAttributeMultiprocessorCount, dev) != hipSuccess) { grid = -1; return; }
        if (hipFuncSetAttribute((const void*)mk_fwd, hipFuncAttributeMaxDynamicSharedMemorySize, LDS_BYTES) != hipSuccess) { fprintf(stderr, "kernel_launch: hipFuncSetAttribute failed\n"); grid = -1; return; }
        if (hipOccupancyMaxActiveBlocksPerMultiprocessor(&per_cu, (const void*)mk_fwd, NWAVES * 64, LDS_BYTES) != hipSuccess || per_cu < 1) fprintf(stderr, "kernel_launch: occupancy query reports %d\n", per_cu);
        (void)hipGetLastError();
        grid = cus;
    }
    if (grid < 0) return;
    hipMemsetAsync((char*)d_ws + WS_CTL, 0, CTL_ZERO_BYTES, stream);
    Args a; memset(&a, 0, sizeof a);
    for (int i = 0; i < 25; ++i) a.in[i] = (const float*)d_in[i];
    a.out = (float*)d_out; a.ws = (unsigned char*)d_ws;
#ifdef MK_PROBE_P1
    for (int li = 0; li < N_PHASES; ++li) {
        a.ph_lo = li; a.ph_hi = li + 1;
#ifdef MK_PROBE_P1_AT10
        if (li == 10) { a.ph_lo = 1; a.ph_hi = 2; a.probe = 1; hipLaunchKernelGGL(mk_fwd, dim3(grid), dim3(NWAVES * 64), LDS_BYTES, stream, a); a.probe = 0; a.ph_lo = li; a.ph_hi = li + 1; }
#else
        if (li == 1) { a.probe = 1; hipLaunchKernelGGL(mk_fwd, dim3(grid), dim3(NWAVES * 64), LDS_BYTES, stream, a); a.probe = 0; }
#endif
        hipLaunchKernelGGL(mk_fwd, dim3(grid), dim3(NWAVES * 64), LDS_BYTES, stream, a);
    }
#elif defined(MK_PROBE_MOE)
    for (int li = 0; li < N_PHASES; ++li) {
        a.ph_lo = li; a.ph_hi = li + 1;
        if (li == 10) { a.probe = 1; hipLaunchKernelGGL(mk_fwd, dim3(grid), dim3(NWAVES * 64), LDS_BYTES, stream, a); a.probe = 0; }
        hipLaunchKernelGGL(mk_fwd, dim3(grid), dim3(NWAVES * 64), LDS_BYTES, stream, a);
    }
#elif defined(MK_PROBE_DUP)
    for (int li = 0; li < N_PHASES; ++li) {
        a.ph_lo = li; a.ph_hi = li + 1;
        hipLaunchKernelGGL(mk_fwd, dim3(grid), dim3(NWAVES * 64), LDS_BYTES, stream, a);
        if (li == MK_PROBE_DUP) { if (li == 9) hipMemsetAsync((char*)d_ws + WS_CTL + CW_CNT * 4, 0, 32 * 64 * 4, stream); hipLaunchKernelGGL(mk_fwd, dim3(grid), dim3(NWAVES * 64), LDS_BYTES, stream, a); }
    }
#else
    constexpr int NL = MK_N_LAUNCHES;
    for (int li = 0; li < NL; ++li) {
        a.ph_lo = (NL == 1) ? 0 : li; a.ph_hi = (NL == 1) ? N_PHASES : li + 1;
        hipLaunchKernelGGL(mk_fwd, dim3(grid), dim3(NWAVES * 64), LDS_BYTES, stream, a);
    }
#endif
}
```

```cpp
#include <hip/hip_runtime.h>
#include <hip/hip_bf16.h>
#include <cstdio>
#include <cstdint>
#include <cstring>

#define LAS __attribute__((address_space(3)))
#define GAS __attribute__((address_space(1)))
typedef unsigned short bf16_t;
typedef short bf16x8 __attribute__((ext_vector_type(8)));
typedef short s16x4 __attribute__((ext_vector_type(4)));
typedef float f32x4 __attribute__((ext_vector_type(4)));
typedef float f32x2 __attribute__((ext_vector_type(2)));
typedef float f32x16 __attribute__((ext_vector_type(16)));
typedef unsigned u32x4 __attribute__((ext_vector_type(4)));
typedef unsigned u32x2 __attribute__((ext_vector_type(2)));
typedef int v4i32 __attribute__((ext_vector_type(4)));
typedef int v8i32 __attribute__((ext_vector_type(8)));
#define MX_SCALE_A 0x7c7c7c7c
#define MX_SCALE_W 0x7c7c7c7c
constexpr float W_FP8_MUL = 64.f;
__device__ __forceinline__ unsigned pack4_fp8(float a, float b, float c, float d) { int r = __builtin_amdgcn_cvt_pk_fp8_f32(a, b, 0, false); r = __builtin_amdgcn_cvt_pk_fp8_f32(c, d, r, true); return (unsigned)r; }

constexpr int D_MODEL = 2048, BATCH = 2, SEQ = 4096, NTOK = BATCH * SEQ;
constexpr int Q_END = 1024, K_END = 1280, V_END = 1536, P_END = 2560, GA_END = 4608, IN_WIDTH = 6656;
constexpr int ATTN_WIDTH = 1024, POOL_WIDTH = 1024, POOL_GROUP = 256;
constexpr int MEM_LEN = 256, MEM_ROWS = BATCH * MEM_LEN, MEM_WIDTH = 512;
constexpr int N_EXPERTS = 32, TOP_K = 4, D_EXPERT = 2048;
constexpr int ECAP = NTOK;
constexpr int MAX_TILES = 160;
constexpr int SLOT_ROWS = MAX_TILES * 256;
constexpr float NORM_EPS = 1e-6f;
constexpr int F8_PITCH = 2048 + 128;

__device__ __forceinline__ unsigned cvt_pk_bf16(float lo, float hi) { unsigned r; asm volatile("v_cvt_pk_bf16_f32 %0, %1, %2" : "=v"(r) : "v"(lo), "v"(hi)); return r; }
__device__ __forceinline__ float bf_lo(unsigned u) { return __uint_as_float(u << 16); }
__device__ __forceinline__ float bf_hi(unsigned u) { return __uint_as_float(u & 0xffff0000u); }
__device__ __forceinline__ float bf1(bf16_t u) { return __uint_as_float(((unsigned)u) << 16); }
__device__ __forceinline__ float sigmoidf_(float x) { return __builtin_amdgcn_rcpf(1.f + __expf(-x)); }

namespace pg8 {
constexpr int BM = 256, BK = 64, HALF = 128, HTB = HALF * BK * 2, STAGE_BYTES = 8 * HTB, NXCD = 8, WGM = 8;
__host__ __device__ __forceinline__ int lds_byte(int r, int c) { const int st = (r >> 4) * 2 + (c >> 5), rr = r & 15, cc = c & 31, ob = rr * 64 + cc * 2; return st * 1024 + (ob ^ (((ob >> 9) & 1) << 5)); }
__host__ __device__ __forceinline__ void stage_rc(int b, int& R, int& C) { const int st = b / 1024, sb = b % 1024, swz = sb ^ (((sb >> 9) & 1) << 5); R = (st >> 1) * 16 + swz / 64; C = (st & 1) * 32 + (swz % 64) / 2; }
__host__ __device__ __forceinline__ int perm32(int rho) { const int n = rho >> 4, i = rho & 15; return 8 * (i >> 2) + 4 * n + (i & 3); }

struct Unit { int pm, pn, e, aux; };
template <int WGM = 8> __device__ __forceinline__ void tile_order(int L, int nM, int nN, int& pm, int& pn) {
    const int nwg = nM * nN; int wgid = L; { const int q = nwg / NXCD, r = nwg % NXCD, xcd = wgid % NXCD, off = wgid / NXCD; wgid = (xcd < r ? xcd * (q + 1) : r * (q + 1) + (xcd - r) * q) + off; }
    const int nig = WGM * nN, gid = wgid / nig, fm = gid * WGM, gsz = (nM - fm) < WGM ? (nM - fm) : WGM;
    pm = fm + ((wgid % nig) % gsz); pn = (wgid % nig) / gsz;
}

template <class Epi, class Sched, bool ALIGN_EPI, bool SP2, bool FP8 = false, int PROBE = 0>
__device__ __forceinline__ void gemm_phase(LAS unsigned char* lds, const int lda, const int ldb, const int K, const Sched& S, const Epi& E, const size_t kstepB = 128) {
    const int tid = threadIdx.x, wid = __builtin_amdgcn_readfirstlane(tid >> 6), lane = tid & 63, wr = wid >> 2, wc = wid & 3, fr = lane & 15, fq = lane >> 4;
    const int nt = K / BK;
    int sR[2], sC[2];
    unsigned voffB[2], vAc[2][2], vAn[2][2];
#pragma unroll
    for (int i = 0; i < 2; ++i) { stage_rc(tid * 16 + i * 8192, sR[i], sC[i]); const int Rb = Epi::PERM ? ((sR[i] & ~31) + perm32(sR[i] & 31)) : sR[i];
        voffB[i] = (unsigned)(Rb * ldb + sC[i]) * 2u;
        vAc[0][i] = (unsigned)(sR[i] * lda + sC[i]) * 2u; vAc[1][i] = (unsigned)((sR[i] + HALF) * lda + sC[i]) * 2u; }
    const size_t kstep = (size_t)(BK * 2);
    const size_t hstepB = (size_t)HALF * ldb * 2;
    const unsigned ldsw = (unsigned)wid * 1024u;
    const int aoff = lds_byte(wr * 64 + fr, fq * 8), boff = lds_byte(wc * 32 + fr, fq * 8);
#define PG8_SA(b, h) (((b) * 2 + (h)) * HTB)
#define PG8_SB(b, h) ((4 + (b) * 2 + (h)) * HTB)
#define PG8_STAGE(bufoff, gbase, voff) do { if constexpr (PROBE != 2) _Pragma("unroll") for (int _i = 0; _i < 2; ++_i) \
        __builtin_amdgcn_global_load_lds((const unsigned*)((const char*)(gbase) + (voff)[_i]), (LAS unsigned*)(lds + (bufoff) + ldsw + _i * 8192), 16, 0, 0); } while (0)
#define PG8_LDA(dst, b, h) do { if constexpr (FP8) { _Pragma("unroll") for (int m = 0; m < 4; ++m) { const v4i32 _lo = *(const LAS v4i32*)(lds + PG8_SA(b, h) + aoff + m * 2048), _hi = *(const LAS v4i32*)(lds + PG8_SA(b, h) + aoff + m * 2048 + 1024); \
            dst##8[m] = __builtin_shufflevector(_lo, _hi, 0, 1, 2, 3, 4, 5, 6, 7); } } \
        else { _Pragma("unroll") for (int m = 0; m < 4; ++m) _Pragma("unroll") for (int k = 0; k < 2; ++k) dst[m][k] = *(const LAS bf16x8*)(lds + PG8_SA(b, h) + aoff + m * 2048 + k * 1024); } } while (0)
#define PG8_LDB(dst, b, h) do { if constexpr (FP8) { _Pragma("unroll") for (int n = 0; n < 2; ++n) { const v4i32 _lo = *(const LAS v4i32*)(lds + PG8_SB(b, h) + boff + n * 2048), _hi = *(const LAS v4i32*)(lds + PG8_SB(b, h) + boff + n * 2048 + 1024); \
            dst##8[n] = __builtin_shufflevector(_lo, _hi, 0, 1, 2, 3, 4, 5, 6, 7); } } \
        else { _Pragma("unroll") for (int n = 0; n < 2; ++n) _Pragma("unroll") for (int k = 0; k < 2; ++k) dst[n][k] = *(const LAS bf16x8*)(lds + PG8_SB(b, h) + boff + n * 2048 + k * 1024); } } while (0)
#define PG8_MMA(ai, bj, At, Bt) do { __builtin_amdgcn_s_setprio(1); \
        if constexpr (PROBE == 1) { _Pragma("unroll") for (int m = 0; m < 4; ++m) _Pragma("unroll") for (int n = 0; n < 2; ++n) { acc[ai][bj][m][n][0] += __builtin_bit_cast(float, At##8[m][0] ^ Bt##8[n][1]); } } \
        else if constexpr (PROBE == 3) { _Pragma("unroll") for (int m = 0; m < 4; ++m) _Pragma("unroll") for (int n = 0; n < 2; ++n) { \
            const v4i32 _b0 = __builtin_shufflevector(Bt##8[n], Bt##8[n], 0, 1, 2, 3), _b1 = __builtin_shufflevector(Bt##8[n], Bt##8[n], 4, 5, 6, 7), _a0 = __builtin_shufflevector(At##8[m], At##8[m], 0, 1, 2, 3), _a1 = __builtin_shufflevector(At##8[m], At##8[m], 4, 5, 6, 7); \
            acc[ai][bj][m][n] = __builtin_amdgcn_mfma_f32_16x16x32_bf16(__builtin_bit_cast(bf16x8, _b0), __builtin_bit_cast(bf16x8, _a0), acc[ai][bj][m][n], 0, 0, 0); \
            acc[ai][bj][m][n] = __builtin_amdgcn_mfma_f32_16x16x32_bf16(__builtin_bit_cast(bf16x8, _b1), __builtin_bit_cast(bf16x8, _a1), acc[ai][bj][m][n], 0, 0, 0); } } \
        else if constexpr (FP8) { _Pragma("unroll") for (int m = 0; m < 4; ++m) _Pragma("unroll") for (int n = 0; n < 2; ++n) \
            acc[ai][bj][m][n] = __builtin_amdgcn_mfma_scale_f32_16x16x128_f8f6f4(Bt##8[n], At##8[m], acc[ai][bj][m][n], 0, 0, 0, MX_SCALE_W, 0, MX_SCALE_A); } \
        else { _Pragma("unroll") for (int m = 0; m < 4; ++m) _Pragma("unroll") for (int n = 0; n < 2; ++n) _Pragma("unroll") for (int k = 0; k < 2; ++k) \
            acc[ai][bj][m][n] = __builtin_amdgcn_mfma_f32_16x16x32_bf16(Bt[n][k], At[m][k], acc[ai][bj][m][n], 0, 0, 0); } \
        __builtin_amdgcn_s_setprio(0); } while (0)
#define PG8_WAIT_V(n) asm volatile("s_waitcnt vmcnt(" #n ")" ::: "memory")
#define PG8_WAIT_L(n) asm volatile("s_waitcnt lgkmcnt(" #n ")" ::: "memory")
#define PG8_BAR __builtin_amdgcn_s_barrier()
#define PG8_SCHED __builtin_amdgcn_sched_barrier(0)
    Unit cur, nxt; int ui = 0;
    if (!S.next(0, cur)) return;
    f32x4 acc[2][2][4][2];
    bf16x8 At[4][2], B0[2][2], B1[2][2]; v8i32 At8[4], B08[2], B18[2];
    const char* cA = S.a_ptr(cur); const char* cB = S.b_ptr(cur);
    if constexpr (Sched::GATHER) { S.a_voff(cur, vAc, sR, sC); }
    if constexpr (SP2) {
        PG8_STAGE(PG8_SB(0, 0), cB, voffB); PG8_STAGE(PG8_SB(0, 1), cB + hstepB, voffB); PG8_STAGE(PG8_SA(0, 0), cA, vAc[0]); PG8_STAGE(PG8_SA(0, 1), cA, vAc[1]);
        if (wr == 1) PG8_BAR;
        PG8_WAIT_V(2); PG8_BAR;
        PG8_STAGE(PG8_SB(1, 0), cB + kstepB, voffB); PG8_STAGE(PG8_SA(1, 0), cA + kstep, vAc[0]); PG8_STAGE(PG8_SB(1, 1), cB + hstepB + kstepB, voffB);
        PG8_WAIT_V(6); PG8_BAR;
    } else {
        PG8_STAGE(PG8_SB(0, 0), cB, voffB); PG8_STAGE(PG8_SA(0, 0), cA, vAc[0]); PG8_STAGE(PG8_SB(0, 1), cB + hstepB, voffB); PG8_STAGE(PG8_SA(0, 1), cA, vAc[1]);
        if (wr == 1) PG8_BAR;
        PG8_WAIT_V(4); PG8_BAR;
        PG8_STAGE(PG8_SB(1, 0), cB + kstepB, voffB); PG8_STAGE(PG8_SA(1, 0), cA + kstep, vAc[0]); PG8_STAGE(PG8_SB(1, 1), cB + hstepB + kstepB, voffB);
        PG8_WAIT_V(6); PG8_BAR;
    }
    constexpr bool LOOKAHEAD = Sched::GATHER || Epi::HAS_BIAS;
    bool has_next = false;
    int gtok[2][2]; f32x4 bpre[2][2];
    if constexpr (LOOKAHEAD) { has_next = S.next(1, nxt);
        if constexpr (Sched::GATHER) { if (has_next) S.a_tok(nxt, gtok, sR); }
        if constexpr (Epi::HAS_BIAS) E.load_bias(cur, wc, fq, bpre); }
    for (;;) {
        if constexpr (!LOOKAHEAD) has_next = S.next(ui + 1, nxt);
        const char* nA = has_next ? S.a_ptr(nxt) : cA; const char* nB = has_next ? S.b_ptr(nxt) : cB;
        if constexpr (Epi::HAS_BIAS) E.init_from(acc, bpre); else E.init(acc, cur, wc, fq);
        if constexpr (Sched::GATHER) { if (has_next) S.a_voff_from_tok(gtok, vAn, sC); }
        for (int t = 0; t < nt; t += 2) {
            const bool last = (t == nt - 2);
            const char* a1 = cA + (size_t)(t + 1) * kstep;
            const char* a2 = last ? nA : cA + (size_t)(t + 2) * kstep; const char* b2 = last ? nB : cB + (size_t)(t + 2) * kstepB;
            const char* a3 = a2 + kstep; const char* b3 = b2 + kstepB;
            if constexpr (SP2) {
            PG8_LDB(B0, 0, 0); PG8_LDB(B1, 0, 1); PG8_SCHED; PG8_LDA(At, 0, 0); PG8_STAGE(PG8_SA(1, 1), a1, vAc[1]);
            if constexpr (Sched::GATHER) { if (last && has_next) {
#pragma unroll
                for (int h = 0; h < 2; ++h)
#pragma unroll
                    for (int i = 0; i < 2; ++i) vAc[h][i] = vAn[h][i]; } }
            PG8_WAIT_V(8); PG8_WAIT_L(0); PG8_BAR; PG8_MMA(0, 0, At, B0); PG8_MMA(0, 1, At, B1); PG8_BAR; PG8_SCHED;
            PG8_LDA(At, 0, 1); PG8_STAGE(PG8_SB(0, 0), b2, voffB); PG8_STAGE(PG8_SB(0, 1), b2 + hstepB, voffB); PG8_STAGE(PG8_SA(0, 0), a2, vAc[0]);
            PG8_WAIT_V(8); PG8_WAIT_L(0); PG8_BAR; PG8_MMA(1, 0, At, B0); PG8_MMA(1, 1, At, B1); PG8_BAR; PG8_SCHED;
            PG8_LDB(B0, 1, 0); PG8_LDB(B1, 1, 1); PG8_SCHED; PG8_LDA(At, 1, 0); PG8_STAGE(PG8_SA(0, 1), a2, vAc[1]);
            PG8_WAIT_V(8); PG8_WAIT_L(0); PG8_BAR; PG8_MMA(0, 0, At, B0); PG8_MMA(0, 1, At, B1); PG8_BAR; PG8_SCHED;
            PG8_LDA(At, 1, 1); PG8_STAGE(PG8_SB(1, 0), b3, voffB); PG8_STAGE(PG8_SB(1, 1), b3 + hstepB, voffB); PG8_STAGE(PG8_SA(1, 0), a3, vAc[0]);
            PG8_WAIT_V(8); PG8_WAIT_L(0); PG8_BAR; PG8_MMA(1, 0, At, B0); PG8_MMA(1, 1, At, B1); PG8_BAR; PG8_SCHED;
            } else {
            PG8_LDB(B0, 0, 0); PG8_SCHED; PG8_LDA(At, 0, 0); PG8_STAGE(PG8_SA(1, 1), a1, vAc[1]);
            if constexpr (Sched::GATHER) { if (last && has_next) {
#pragma unroll
                for (int h = 0; h < 2; ++h)
#pragma unroll
                    for (int i = 0; i < 2; ++i) vAc[h][i] = vAn[h][i]; } }
            PG8_WAIT_L(8); PG8_BAR; PG8_WAIT_L(0); PG8_MMA(0, 0, At, B0); PG8_BAR; PG8_SCHED;
            PG8_LDB(B1, 0, 1); PG8_STAGE(PG8_SB(0, 0), b2, voffB);
            PG8_BAR; PG8_WAIT_L(0); PG8_MMA(0, 1, At, B1); PG8_BAR;
            PG8_LDA(At, 0, 1); PG8_STAGE(PG8_SA(0, 0), a2, vAc[0]);
            PG8_BAR; PG8_WAIT_L(0); PG8_MMA(1, 0, At, B0); PG8_BAR; PG8_SCHED;
            PG8_STAGE(PG8_SB(0, 1), b2 + hstepB, voffB);
            PG8_WAIT_V(6); PG8_BAR; PG8_MMA(1, 1, At, B1); PG8_BAR;
            PG8_LDB(B0, 1, 0); PG8_SCHED; PG8_LDA(At, 1, 0); PG8_STAGE(PG8_SA(0, 1), a2, vAc[1]);
            PG8_WAIT_L(8); PG8_BAR; PG8_WAIT_L(0); PG8_MMA(0, 0, At, B0); PG8_BAR; PG8_SCHED;
            PG8_LDB(B1, 1, 1); PG8_STAGE(PG8_SB(1, 0), b3, voffB);
            PG8_BAR; PG8_WAIT_L(0); PG8_MMA(0, 1, At, B1); PG8_BAR;
            PG8_LDA(At, 1, 1); PG8_STAGE(PG8_SA(1, 0), a3, vAc[0]);
            PG8_BAR; PG8_WAIT_L(0); PG8_MMA(1, 0, At, B0); PG8_BAR; PG8_SCHED;
            PG8_STAGE(PG8_SB(1, 1), b3 + hstepB, voffB);
            PG8_WAIT_V(6); PG8_BAR; PG8_MMA(1, 1, At, B1); PG8_BAR;
            }
        }
        if constexpr (ALIGN_EPI) { if (wr == 0) PG8_BAR; }
        if constexpr (PROBE == 7) { f32x4 s_ = acc[0][0][0][0];
#pragma unroll
            for (int a = 0; a < 2; ++a)
#pragma unroll
                for (int b = 0; b < 2; ++b)
#pragma unroll
                    for (int m = 0; m < 4; ++m)
#pragma unroll
                        for (int n = 0; n < 2; ++n) s_ = s_ + acc[a][b][m][n];
            if (s_[0] + s_[1] + s_[2] + s_[3] == 1.2345678f) *(volatile float*)S.a_ptr(cur) = s_[0]; }
        Unit nn; bool has2 = false;
        if constexpr (LOOKAHEAD) { has2 = has_next && S.next(ui + 2, nn);
            if constexpr (Epi::HAS_BIAS) { if (has_next) E.load_bias(nxt, wc, fq, bpre); }
            if constexpr (Sched::GATHER) { if (has2) S.a_tok(nn, gtok, sR); } }
        if constexpr (PROBE != 6 && PROBE != 7) E(acc, cur, wr, wc, fr, fq);
        if (!has_next) break;
        cur = nxt; cA = nA; cB = nB; ++ui;
        if constexpr (LOOKAHEAD) { nxt = nn; has_next = has2; }
        if constexpr (ALIGN_EPI) { if (wr == 1) PG8_BAR; }
    }
    PG8_WAIT_V(0);
    if constexpr (!ALIGN_EPI) { if (wr == 0) PG8_BAR; }
    PG8_BAR;
#undef PG8_SA
#undef PG8_SB
#undef PG8_STAGE
#undef PG8_LDA
#undef PG8_LDB
#undef PG8_MMA
#undef PG8_WAIT_V
#undef PG8_WAIT_L
#undef PG8_BAR
#undef PG8_SCHED
}
}
using pg8::Unit;
template <int WGM = 8> struct DenseSchedT {
    static constexpr bool GATHER = false;
    const char* A; const char* Bt; int lda, ldb, nM, nN, G, c;
    __device__ __forceinline__ bool next(int i, Unit& u) const { const int L = i * G + c; if (L >= nM * nN) return false; pg8::tile_order<WGM>(L, nM, nN, u.pm, u.pn); u.e = 0; u.aux = 0; return true; }
    __device__ __forceinline__ const char* a_ptr(const Unit& u) const { return A + (size_t)u.pm * 256 * lda * 2; }
    __device__ __forceinline__ const char* b_ptr(const Unit& u) const { return Bt + (size_t)u.pn * 256 * ldb * 2; }
};
using DenseSched = DenseSchedT<8>;
using DenseSched4 = DenseSchedT<4>;
struct ProjSched {
    static constexpr bool GATHER = false;
    const char* A; const char* Bt; const char* A2; const char* Bt2; int G, c;
    __device__ __forceinline__ bool next(int i, Unit& u) const { const int L = i * G + c; constexpr int n1 = 32 * 26;
        if (L < n1) { pg8::tile_order<4>(L, 32, 26, u.pm, u.pn); u.e = 0; u.aux = 0; return true; }
        if (L < n1 + 8) { u.pm = (L - n1) >> 2; u.pn = (L - n1) & 3; u.e = 1; u.aux = 0; return true; }
        return false; }
    __device__ __forceinline__ const char* a_ptr(const Unit& u) const { return (u.e ? A2 : A) + (size_t)u.pm * 256 * 2048 * 2; }
    __device__ __forceinline__ const char* b_ptr(const Unit& u) const { return (u.e ? Bt2 : Bt) + (size_t)u.pn * 256 * 2048 * 2; }
};
struct PoolSched {
    static constexpr bool GATHER = false;
    const char* A; const char* Bt; int G, c;
    __device__ __forceinline__ bool next(int i, Unit& u) const { const int L = i * G + c; if (L >= 128) return false; u.pm = L >> 2; u.pn = L & 3; u.e = 0; u.aux = 0; return true; }
    __device__ __forceinline__ const char* a_ptr(const Unit& u) const { return A + ((size_t)u.pm * 256 * 1024 + u.pn * 256) * 2; }
    __device__ __forceinline__ const char* b_ptr(const Unit& u) const { return Bt + (size_t)u.pn * 256 * 256 * 2; }
};
struct MixSched {
    static constexpr bool GATHER = false;
    const char* A0; const char* B0; const char* A1; const char* B1; int G, c;
    __device__ __forceinline__ bool next(int i, Unit& u) const { const int L = (i >> 1) * G + c; if (L >= 32 * 8) return false; pg8::tile_order<4>(L, 32, 8, u.pm, u.pn); u.e = i & 1; u.aux = 0; return true; }
    __device__ __forceinline__ const char* a_ptr(const Unit& u) const { return (u.e ? A1 : A0) + (size_t)u.pm * 256 * 1024 * 2; }
    __device__ __forceinline__ const char* b_ptr(const Unit& u) const { return (u.e ? B1 : B0) + (size_t)u.pn * 256 * 1024 * 2; }
};
struct MoeTab { const LAS int* tstart; const LAS int* cnt; const LAS int* tile_e; };
template <int NPN> __device__ __forceinline__ bool moe_unit(const MoeTab& T, int i, int G, int c, Unit& u) {
    const int NU = __builtin_amdgcn_readfirstlane(T.tstart[32]) * NPN; int L;
    if ((G & 7) == 0) { const int x = c & 7, j = c >> 3, per = G >> 3, lo = (int)(((long)NU * x) >> 3), hi = (int)(((long)NU * (x + 1)) >> 3); L = lo + j + i * per; if (L >= hi) return false; }
    else { L = i * G + c; if (L >= NU) return false; }
    const int tau_lin = L / NPN;
    const int e = __builtin_amdgcn_readfirstlane(T.tile_e[tau_lin]); const int ts0 = __builtin_amdgcn_readfirstlane(T.tstart[e]), ts1 = __builtin_amdgcn_readfirstlane(T.tstart[e + 1]);
    const int v = L - ts0 * NPN, nte = ts1 - ts0;
    u.e = e; u.pn = v / nte; u.aux = v - u.pn * nte; u.pm = ts0 + u.aux; return true;
}
struct Moe1Sched {
    static constexpr bool GATHER = true;
    const char* A; const char* Bt; const int* list_tok; MoeTab T; int G, c; int pflag = 0;
    __device__ __forceinline__ bool next(int i, Unit& u) const { return moe_unit<16>(T, i, G, c, u); }
    __device__ __forceinline__ const char* a_ptr(const Unit&) const { return A; }
    __device__ __forceinline__ const char* b_ptr(const Unit& u) const { if (pflag & 1) return Bt; return Bt + ((size_t)u.e * 16 + (size_t)u.pn) * (16 * 32768); }
    __device__ __forceinline__ void a_tok(const Unit& u, int (&tk)[2][2], const int (&sR)[2]) const {
        const int cnt = __builtin_amdgcn_readfirstlane(T.cnt[u.e]); const int* lst = list_tok + (size_t)u.e * ECAP;
#pragma unroll
        for (int h = 0; h < 2; ++h)
#pragma unroll
            for (int i = 0; i < 2; ++i) { int pos = u.aux * 256 + h * 128 + sR[i]; pos = pos < cnt ? pos : cnt - 1; tk[h][i] = (pflag & 2) ? (h * 128 + sR[i]) : lst[pos]; }
    }
    __device__ __forceinline__ void a_voff_from_tok(const int (&tk)[2][2], unsigned (&v)[2][2], const int (&sC)[2]) const {
#pragma unroll
        for (int h = 0; h < 2; ++h)
#pragma unroll
            for (int i = 0; i < 2; ++i) v[h][i] = (unsigned)(tk[h][i] * F8_PITCH + sC[i] * 2);
    }
    __device__ __forceinline__ void a_voff(const Unit& u, unsigned (&v)[2][2], const int (&sR)[2], const int (&sC)[2]) const { int tk[2][2]; a_tok(u, tk, sR); a_voff_from_tok(tk, v, sC); }
};
struct Moe2Sched {
    static constexpr bool GATHER = true;
    const char* A; const char* Bt; MoeTab T; int G, c;
    __device__ __forceinline__ bool next(int i, Unit& u) const { return moe_unit<8>(T, i, G, c, u); }
    __device__ __forceinline__ const char* a_ptr(const Unit&) const { return A; }
    __device__ __forceinline__ const char* b_ptr(const Unit& u) const { return Bt + ((size_t)u.e * 8 + (size_t)u.pn) * (16 * 32768); }
    __device__ __forceinline__ void a_tok(const Unit& u, int (&tk)[2][2], const int (&sR)[2]) const {
#pragma unroll
        for (int h = 0; h < 2; ++h)
#pragma unroll
            for (int i = 0; i < 2; ++i) tk[h][i] = u.pm * 256 + h * 128 + sR[i];
    }
    __device__ __forceinline__ void a_voff_from_tok(const int (&tk)[2][2], unsigned (&v)[2][2], const int (&sC)[2]) const {
#pragma unroll
        for (int h = 0; h < 2; ++h)
#pragma unroll
            for (int i = 0; i < 2; ++i) v[h][i] = (unsigned)(tk[h][i] * F8_PITCH + sC[i] * 2);
    }
    __device__ __forceinline__ void a_voff(const Unit& u, unsigned (&v)[2][2], const int (&sR)[2], const int (&sC)[2]) const { int tk[2][2]; a_tok(u, tk, sR); a_voff_from_tok(tk, v, sC); }
};

#define EPI_LOOP_ROWS for (int ai = 0; ai < 2; ++ai) _Pragma("unroll") for (int m = 0; m < 4; ++m)
struct EpiProj {
    static constexpr bool PERM = true; static constexpr bool HAS_BIAS = false;
    __device__ __forceinline__ void init(f32x4 (&acc)[2][2][4][2], const Unit&, int, int) const {
#pragma unroll
        for (int a = 0; a < 2; ++a)
#pragma unroll
            for (int b = 0; b < 2; ++b)
#pragma unroll
                for (int m = 0; m < 4; ++m)
#pragma unroll
                    for (int n = 0; n < 2; ++n) acc[a][b][m][n] = (f32x4){0.f, 0.f, 0.f, 0.f}; }
    bf16_t* proj; bf16_t* kvc;
    __device__ __forceinline__ void operator()(const f32x4 (&acc)[2][2][4][2], const Unit& u, int wr, int wc, int fr, int fq) const {
        const bool sg = (u.e == 0) && (u.pn >= 10); const int ldc = u.e ? 1024 : IN_WIDTH; bf16_t* base = (u.e ? kvc : proj) + (size_t)(u.pm * 256 + wr * 64 + fr) * ldc + u.pn * 256 + wc * 32 + 8 * fq;
#pragma unroll
        EPI_LOOP_ROWS { bf16_t* rowp = base + (size_t)(ai * 128 + m * 16) * ldc;
#pragma unroll
            for (int bj = 0; bj < 2; ++bj) { f32x4 v0 = acc[ai][bj][m][0], v1 = acc[ai][bj][m][1];
                if (sg) { v0 = (f32x4){sigmoidf_(v0[0]), sigmoidf_(v0[1]), sigmoidf_(v0[2]), sigmoidf_(v0[3])}; v1 = (f32x4){sigmoidf_(v1[0]), sigmoidf_(v1[1]), sigmoidf_(v1[2]), sigmoidf_(v1[3])}; }
                u32x4 w; w.x = cvt_pk_bf16(v0[0], v0[1]); w.y = cvt_pk_bf16(v0[2], v0[3]); w.z = cvt_pk_bf16(v1[0], v1[1]); w.w = cvt_pk_bf16(v1[2], v1[3]);
                *(u32x4*)(rowp + bj * 128) = w; } }
    }
};
template <int MODE  > struct EpiBf16 {
    static constexpr bool PERM = true; static constexpr bool HAS_BIAS = false;
    __device__ __forceinline__ void init(f32x4 (&acc)[2][2][4][2], const Unit&, int, int) const {
#pragma unroll
        for (int a = 0; a < 2; ++a)
#pragma unroll
            for (int b = 0; b < 2; ++b)
#pragma unroll
                for (int m = 0; m < 4; ++m)
#pragma unroll
                    for (int n = 0; n < 2; ++n) acc[a][b][m][n] = (f32x4){0.f, 0.f, 0.f, 0.f}; }
    bf16_t* O; int ldc; int col_mul;
    const float* cscale; const LAS float* rscale;
    __device__ __forceinline__ void operator()(const f32x4 (&acc)[2][2][4][2], const Unit& u, int wr, int wc, int fr, int fq) const {
        const int col0 = u.pn * col_mul + wc * 32 + 8 * fq; bf16_t* base = O + (size_t)(u.pm * 256 + wr * 64 + fr) * ldc + col0;
        f32x4 cs[2][2];
        if (MODE == 1) {
#pragma unroll
            for (int bj = 0; bj < 2; ++bj)
#pragma unroll
                for (int n = 0; n < 2; ++n) cs[bj][n] = *(const f32x4*)(cscale + col0 + bj * 128 + 4 * n); }
#pragma unroll
        EPI_LOOP_ROWS { bf16_t* rowp = base + (size_t)(ai * 128 + m * 16) * ldc; float rs = 1.f; if (MODE == 2) rs = rscale[ai * 128 + wr * 64 + m * 16 + fr];
#pragma unroll
            for (int bj = 0; bj < 2; ++bj) { f32x4 v0 = acc[ai][bj][m][0], v1 = acc[ai][bj][m][1];
                if (MODE == 1) { v0 = v0 * cs[bj][0]; v1 = v1 * cs[bj][1]; }
                if (MODE == 2) { v0 = v0 * rs; v1 = v1 * rs; }
                u32x4 w; w.x = cvt_pk_bf16(v0[0], v0[1]); w.y = cvt_pk_bf16(v0[2], v0[3]); w.z = cvt_pk_bf16(v1[0], v1[1]); w.w = cvt_pk_bf16(v1[2], v1[3]);
                *(u32x4*)(rowp + bj * 128) = w; } }
    }
};
struct EpiMix {
    static constexpr bool PERM = true; static constexpr bool HAS_BIAS = false;
    __device__ __forceinline__ void init(f32x4 (&acc)[2][2][4][2], const Unit& u, int, int) const {
        if (u.e == 0) {
#pragma unroll
        for (int a = 0; a < 2; ++a)
#pragma unroll
            for (int b = 0; b < 2; ++b)
#pragma unroll
                for (int m = 0; m < 4; ++m)
#pragma unroll
                    for (int n = 0; n < 2; ++n) acc[a][b][m][n] = (f32x4){0.f, 0.f, 0.f, 0.f}; } }
    const bf16_t* proj; bf16_t* scratch; bf16_t* mixed;
    __device__ __forceinline__ void operator()(f32x4 (&acc)[2][2][4][2], const Unit& u, int wr, int wc, int fr, int fq) const {
        const int row0 = u.pm * 256 + wr * 64 + fr, col0 = u.pn * 256 + wc * 32 + 8 * fq;
        const bf16_t* gab = proj + (size_t)row0 * IN_WIDTH + P_END + col0; const bf16_t* gpb = proj + (size_t)row0 * IN_WIDTH + GA_END + col0;
        if (u.e == 0) {
#pragma unroll
            EPI_LOOP_ROWS { const size_t ro = (size_t)(ai * 128 + m * 16);
#pragma unroll
                for (int bj = 0; bj < 2; ++bj) { const u32x4 a = *(const u32x4*)(gab + ro * IN_WIDTH + bj * 128), p = *(const u32x4*)(gpb + ro * IN_WIDTH + bj * 128);
                    const f32x4 a0 = {bf_lo(a.x), bf_hi(a.x), bf_lo(a.y), bf_hi(a.y)}, a1 = {bf_lo(a.z), bf_hi(a.z), bf_lo(a.w), bf_hi(a.w)};
                    f32x4 r0, r1;
                    r0[0] = __builtin_amdgcn_rcpf(fmaxf(bf_lo(p.x), 1e-30f)); r0[1] = __builtin_amdgcn_rcpf(fmaxf(bf_hi(p.x), 1e-30f)); r0[2] = __builtin_amdgcn_rcpf(fmaxf(bf_lo(p.y), 1e-30f)); r0[3] = __builtin_amdgcn_rcpf(fmaxf(bf_hi(p.y), 1e-30f));
                    r1[0] = __builtin_amdgcn_rcpf(fmaxf(bf_lo(p.z), 1e-30f)); r1[1] = __builtin_amdgcn_rcpf(fmaxf(bf_hi(p.z), 1e-30f)); r1[2] = __builtin_amdgcn_rcpf(fmaxf(bf_lo(p.w), 1e-30f)); r1[3] = __builtin_amdgcn_rcpf(fmaxf(bf_hi(p.w), 1e-30f));
                    acc[ai][bj][m][0] = acc[ai][bj][m][0] * (a0 * r0); acc[ai][bj][m][1] = acc[ai][bj][m][1] * (a1 * r1); } }
        } else {
#pragma unroll
            EPI_LOOP_ROWS { const size_t ro = (size_t)(ai * 128 + m * 16);
#pragma unroll
                for (int bj = 0; bj < 2; ++bj) { const u32x4 p = *(const u32x4*)(gpb + ro * IN_WIDTH + bj * 128);
                    const f32x4 v0 = acc[ai][bj][m][0] * (f32x4){bf_lo(p.x), bf_hi(p.x), bf_lo(p.y), bf_hi(p.y)}, v1 = acc[ai][bj][m][1] * (f32x4){bf_lo(p.z), bf_hi(p.z), bf_lo(p.w), bf_hi(p.w)};
                    u32x4 w; w.x = cvt_pk_bf16(v0[0], v0[1]); w.y = cvt_pk_bf16(v0[2], v0[3]); w.z = cvt_pk_bf16(v1[0], v1[1]); w.w = cvt_pk_bf16(v1[2], v1[3]);
                    *(u32x4*)(mixed + ((size_t)row0 + ro) * D_MODEL + col0 + bj * 128) = w; } }
        }
    }
};
template <bool RES_BF16, bool SS> struct EpiResid {
    static constexpr bool PERM = false; static constexpr bool HAS_BIAS = false;
    __device__ __forceinline__ void init(f32x4 (&acc)[2][2][4][2], const Unit&, int, int) const {
#pragma unroll
        for (int a = 0; a < 2; ++a)
#pragma unroll
            for (int b = 0; b < 2; ++b)
#pragma unroll
                for (int m = 0; m < 4; ++m)
#pragma unroll
                    for (int n = 0; n < 2; ++n) acc[a][b][m][n] = (f32x4){0.f, 0.f, 0.f, 0.f}; }
    const void* resid; bf16_t* ob; float* ss;
    __device__ __forceinline__ void operator()(const f32x4 (&acc)[2][2][4][2], const Unit& u, int wr, int wc, int fr, int fq) const {
        const int row0 = u.pm * 256 + wr * 64 + fr, col0 = u.pn * 256 + wc * 32 + 4 * fq;
#pragma unroll
        EPI_LOOP_ROWS { const size_t off = (size_t)(row0 + ai * 128 + m * 16) * D_MODEL + col0; float s = 0.f;
#pragma unroll
            for (int bj = 0; bj < 2; ++bj)
#pragma unroll
                for (int n = 0; n < 2; ++n) { f32x4 r;
                    if (RES_BF16) { const u32x2 t = *(const u32x2*)((const bf16_t*)resid + off + bj * 128 + n * 16); r = (f32x4){bf_lo(t.x), bf_hi(t.x), bf_lo(t.y), bf_hi(t.y)}; }
                    else r = *(const f32x4*)((const float*)resid + off + bj * 128 + n * 16);
                    const f32x4 v = acc[ai][bj][m][n] + r;
                    if (SS) s += (v[0] * v[0] + v[1] * v[1]) + (v[2] * v[2] + v[3] * v[3]);
                    u32x2 w; w.x = cvt_pk_bf16(v[0], v[1]); w.y = cvt_pk_bf16(v[2], v[3]); *(u32x2*)(ob + off + bj * 128 + n * 16) = w; }
            if (SS) { s += __shfl_xor(s, 16); s += __shfl_xor(s, 32); if (fq == 0) ss[(size_t)(row0 + ai * 128 + m * 16) * 32 + u.pn * 4 + wc] = s; } }
    }
};
struct EpiSwiglu {
    static constexpr bool PERM = true; static constexpr int NB = 4096; static constexpr bool HAS_BIAS = true;
    __device__ __forceinline__ void load_bias(const Unit& u, int wc, int fq, f32x4 (&b)[2][2]) const {
        const float* bp = bias + (size_t)u.e * NB + u.pn * 256 + wc * 32 + 8 * fq;
#pragma unroll
        for (int bj = 0; bj < 2; ++bj)
#pragma unroll
            for (int n = 0; n < 2; ++n) b[bj][n] = *(const f32x4*)(bp + bj * 128 + 4 * n); }
    __device__ __forceinline__ void init_from(f32x4 (&acc)[2][2][4][2], const f32x4 (&b)[2][2]) const {
#pragma unroll
        for (int a = 0; a < 2; ++a)
#pragma unroll
            for (int bj = 0; bj < 2; ++bj)
#pragma unroll
                for (int m = 0; m < 4; ++m)
#pragma unroll
                    for (int n = 0; n < 2; ++n) acc[a][bj][m][n] = b[bj][n]; }
    const float* bias; unsigned char* act; int pflag = 0;
    __device__ __forceinline__ void init(f32x4 (&acc)[2][2][4][2], const Unit& u, int wc, int fq) const {
        const float* bp = bias + (size_t)u.e * NB + u.pn * 256 + wc * 32 + 8 * fq;
#pragma unroll
        for (int b = 0; b < 2; ++b)
#pragma unroll
            for (int n = 0; n < 2; ++n) { const f32x4 bv = *(const f32x4*)(bp + b * 128 + 4 * n);
#pragma unroll
                for (int a = 0; a < 2; ++a)
#pragma unroll
                    for (int m = 0; m < 4; ++m) acc[a][b][m][n] = bv; } }
    __device__ __forceinline__ void operator()(const f32x4 (&acc)[2][2][4][2], const Unit& u, int wr, int wc, int fr, int fq) const {
        unsigned char* base = act + (size_t)(u.pm * 256 + wr * 64 + fq * 16 + fr) * F8_PITCH + u.pn * 128 + wc * 16;
#pragma unroll
        for (int ai = 0; ai < 2; ++ai)
#pragma unroll
            for (int bj = 0; bj < 2; ++bj) { unsigned pk[4];
#pragma unroll
                for (int m = 0; m < 4; ++m) { const f32x4 v0 = acc[ai][bj][m][0], v1 = acc[ai][bj][m][1]; float o[4];
                    const float g[4] = {v0[0], v0[2], v1[0], v1[2]}, l[4] = {v0[1], v0[3], v1[1], v1[3]};
#pragma unroll
                    for (int j = 0; j < 4; ++j) { const float xg = __builtin_amdgcn_fmed3f(g[j], -3.0e38f, 7.f), xl = __builtin_amdgcn_fmed3f(l[j], -7.f, 7.f);
                        o[j] = xg * __builtin_amdgcn_rcpf(1.f + __builtin_amdgcn_exp2f(xg * -2.4554669595930156f)) * (xl + 1.f); }
                    pk[m] = pack4_fp8(o[0], o[1], o[2], o[3]); }
                const auto s01 = __builtin_amdgcn_permlane16_swap(pk[0], pk[1], false, false), s23 = __builtin_amdgcn_permlane16_swap(pk[2], pk[3], false, false);
                const auto t02 = __builtin_amdgcn_permlane32_swap(s01[0], s23[0], false, false), t13 = __builtin_amdgcn_permlane32_swap(s01[1], s23[1], false, false);
                const u32x4 w = {t02[0], t13[0], t02[1], t13[1]};
                if (!(pflag & 1) || w.x == 0x12345678u) *(u32x4*)(base + (size_t)(ai * 128) * F8_PITCH + bj * 64) = w; }
    }
};
struct EpiDown {
    static constexpr bool PERM = true; static constexpr int NB = 2048; static constexpr bool HAS_BIAS = true;
    __device__ __forceinline__ void load_bias(const Unit& u, int wc, int fq, f32x4 (&b)[2][2]) const {
        const float* bp = bias + (size_t)u.e * NB + u.pn * 256 + wc * 32 + 8 * fq;
#pragma unroll
        for (int bj = 0; bj < 2; ++bj)
#pragma unroll
            for (int n = 0; n < 2; ++n) b[bj][n] = *(const f32x4*)(bp + bj * 128 + 4 * n); }
    __device__ __forceinline__ void init_from(f32x4 (&acc)[2][2][4][2], const f32x4 (&b)[2][2]) const {
#pragma unroll
        for (int a = 0; a < 2; ++a)
#pragma unroll
            for (int bj = 0; bj < 2; ++bj)
#pragma unroll
                for (int m = 0; m < 4; ++m)
#pragma unroll
                    for (int n = 0; n < 2; ++n) acc[a][bj][m][n] = b[bj][n]; }
    const float* bias; unsigned char* ys;
    __device__ __forceinline__ void init(f32x4 (&acc)[2][2][4][2], const Unit& u, int wc, int fq) const {
        const float* bp = bias + (size_t)u.e * NB + u.pn * 256 + wc * 32 + 8 * fq;
#pragma unroll
        for (int b = 0; b < 2; ++b)
#pragma unroll
            for (int n = 0; n < 2; ++n) { const f32x4 bv = *(const f32x4*)(bp + b * 128 + 4 * n);
#pragma unroll
                for (int a = 0; a < 2; ++a)
#pragma unroll
                    for (int m = 0; m < 4; ++m) acc[a][b][m][n] = bv; } }
    __device__ __forceinline__ void operator()(const f32x4 (&acc)[2][2][4][2], const Unit& u, int wr, int wc, int fr, int fq) const {
        const int col0 = u.pn * 256 + wc * 32 + 8 * fq;
        unsigned char* base = ys + (size_t)(u.pm * 256 + wr * 64 + fr) * D_MODEL + col0;
#pragma unroll
        EPI_LOOP_ROWS { unsigned char* rowp = base + (size_t)(ai * 128 + m * 16) * D_MODEL;
#pragma unroll
            for (int bj = 0; bj < 2; ++bj) { const f32x4 v0 = acc[ai][bj][m][0], v1 = acc[ai][bj][m][1];
                u32x2 w; w.x = pack4_fp8(v0[0], v0[1], v0[2], v0[3]); w.y = pack4_fp8(v1[0], v1[1], v1[2], v1[3]);
                *(u32x2*)(rowp + bj * 128) = w; } }
    }
};
namespace attn {
constexpr int D = 128, NW = 8, QBLK = 32, KVBLK = 64, SDEPTH = 2;
constexpr float SCALE = 0.088388347648318440f, THR = 8.f;
constexpr size_t SHM_V = KVBLK * D * 2, SHM_K = KVBLK * D * 2, SHM_ATTN = 2 * SHM_V + 2 * SHM_K + NW * 64 * 4;
#define KSWZ(row, colB) ((row) * 256 + ((colB) ^ (((row) & 7) << 4)))
#define SBAR() __builtin_amdgcn_sched_barrier(0)
__device__ __forceinline__ int crow(int r, int hi) { return (r & 3) + 8 * (r >> 2) + 4 * hi; }
__device__ __forceinline__ void partialSM(f32x16& p0, f32x16& p1, float& m_reg, float& mn, float& alpha) {
  constexpr float C = SCALE * 1.4426950408889634f;
  float pmax = p0[0]; for (int r = 1; r < 16; ++r) pmax = fmaxf(pmax, p0[r]); for (int r = 0; r < 16; ++r) pmax = fmaxf(pmax, p1[r]);
  { auto rr = __builtin_amdgcn_permlane32_swap(__float_as_uint(pmax), __float_as_uint(pmax), false, false);
    pmax = fmaxf(__uint_as_float(rr[0]), __uint_as_float(rr[1])); }
  if (__builtin_expect(__all(pmax - m_reg <= THR / SCALE), 1)) { mn = m_reg; alpha = 1.f; }
  else { mn = fmaxf(m_reg, pmax); alpha = __builtin_amdgcn_exp2f((m_reg - mn) * C); m_reg = mn; }
  float mnC = -mn * C;
  for (int r = 0; r < 16; ++r) p0[r] = fmaf(p0[r], C, mnC); for (int r = 0; r < 16; ++r) p1[r] = fmaf(p1[r], C, mnC);
  for (int r = 0; r < 16; ++r) p0[r] = __builtin_amdgcn_exp2f(p0[r]);
}
__device__ __forceinline__ void finishSM(f32x16& p0, f32x16& p1, float alpha, float& l_reg, bf16x8& pa0, bf16x8& pa1, bf16x8& pa2, bf16x8& pa3) {
  for (int r = 0; r < 16; ++r) p1[r] = __builtin_amdgcn_exp2f(p1[r]);
  float ps = 0; for (int r = 0; r < 16; ++r) ps += p0[r]; for (int r = 0; r < 16; ++r) ps += p1[r];
  { auto rr = __builtin_amdgcn_permlane32_swap(__float_as_uint(ps), __float_as_uint(ps), false, false);
    ps = __uint_as_float(rr[0]) + __uint_as_float(rr[1]); }
  l_reg = l_reg * alpha + ps;
#define PK4(P, BASE, OUT) do { unsigned a0 = cvt_pk_bf16(P[BASE + 0], P[BASE + 1]), a1 = cvt_pk_bf16(P[BASE + 2], P[BASE + 3]);   \
    unsigned b0 = cvt_pk_bf16(P[BASE + 4], P[BASE + 5]), b1 = cvt_pk_bf16(P[BASE + 6], P[BASE + 7]);                              \
    auto r0 = __builtin_amdgcn_permlane32_swap(a0, b0, false, false); auto r1 = __builtin_amdgcn_permlane32_swap(a1, b1, false, false); \
    u32x4 w = {r0[0], r1[0], r0[1], r1[1]}; OUT = *reinterpret_cast<bf16x8*>(&w); } while (0)
  PK4(p0, 0, pa0); PK4(p0, 8, pa1); PK4(p1, 0, pa2); PK4(p1, 8, pa3);
#undef PK4
}
__device__ __forceinline__ void qkt(f32x16& p0, f32x16& p1, const bf16_t* Ks, const bf16x8* qr, int r32, int hi) {
  p0 = f32x16{}; p1 = f32x16{};
  for (int d0 = 0; d0 < 8; ++d0) { int cb = (d0 * 16 + hi * 8) * 2;
    bf16x8 b0 = *reinterpret_cast<const bf16x8*>((const char*)Ks + KSWZ(r32, cb));
    bf16x8 b1 = *reinterpret_cast<const bf16x8*>((const char*)Ks + KSWZ(32 + r32, cb));
    p0 = __builtin_amdgcn_mfma_f32_32x32x16_bf16(b0, qr[d0], p0, 0, 0, 0);
    p1 = __builtin_amdgcn_mfma_f32_32x32x16_bf16(b1, qr[d0], p1, 0, 0, 0); }
}
__device__ __forceinline__ int v_st(int k, int c) { const int kk = (k & ~0xC) | ((k & 4) << 1) | ((k & 8) >> 1); return ((kk >> 3) * 4 + (c >> 5)) * 512 + ((kk & 7) * 32 + (c & 31)) * 2; }
__device__ __forceinline__ int v_rd_base(int lane) { return ((lane & 3) << 3) | (((lane >> 2) & 3) << 6) | (((lane >> 4) & 1) << 5) | (((lane >> 5) & 1) << 8); }
constexpr int v_rd_off(int d0, int ks, int half) { return d0 * 512 + ks * 4096 + half * 2048; }
template <int OFF> __device__ __forceinline__ s16x4 tr_read(int vb) {
  s16x4 r; asm volatile("ds_read_b64_tr_b16 %0, %1 offset:%2" : "=&v"(r) : "v"(vb), "i"(OFF) : "memory"); return r;
}
template <int D0> __device__ __forceinline__ void pv_one(f32x16& od, int vb, bf16x8 pa0, bf16x8 pa1, bf16x8 pa2, bf16x8 pa3) {
  const s16x4 l0 = tr_read<v_rd_off(D0, 0, 0)>(vb), h0 = tr_read<v_rd_off(D0, 0, 1)>(vb), l1 = tr_read<v_rd_off(D0, 1, 0)>(vb), h1 = tr_read<v_rd_off(D0, 1, 1)>(vb);
  const s16x4 l2 = tr_read<v_rd_off(D0, 2, 0)>(vb), h2 = tr_read<v_rd_off(D0, 2, 1)>(vb), l3 = tr_read<v_rd_off(D0, 3, 0)>(vb), h3 = tr_read<v_rd_off(D0, 3, 1)>(vb);
  asm volatile("s_waitcnt lgkmcnt(0)" ::: "memory"); SBAR();
#define PK(L, H) (bf16x8){L[0], L[1], L[2], L[3], H[0], H[1], H[2], H[3]}
  od = __builtin_amdgcn_mfma_f32_32x32x16_bf16(pa0, PK(l0, h0), od, 0, 0, 0);
  od = __builtin_amdgcn_mfma_f32_32x32x16_bf16(pa1, PK(l1, h1), od, 0, 0, 0);
  od = __builtin_amdgcn_mfma_f32_32x32x16_bf16(pa2, PK(l2, h2), od, 0, 0, 0);
  od = __builtin_amdgcn_mfma_f32_32x32x16_bf16(pa3, PK(l3, h3), od, 0, 0, 0);
#undef PK
}
__device__ __forceinline__ void pv_d0(f32x16* o, int vb, bf16x8 pa0, bf16x8 pa1, bf16x8 pa2, bf16x8 pa3) {
  pv_one<0>(o[0], vb, pa0, pa1, pa2, pa3); pv_one<1>(o[1], vb, pa0, pa1, pa2, pa3); pv_one<2>(o[2], vb, pa0, pa1, pa2, pa3); pv_one<3>(o[3], vb, pa0, pa1, pa2, pa3);
}
template <int LDQ, int LDK, int LDO>
__device__ __forceinline__ void attn_dense_body(const bf16_t* __restrict__ Qb, const bf16_t* __restrict__ Kh, const bf16_t* __restrict__ Vh, bf16_t* __restrict__ Ob, int seq, char* lds) {
  const int tid = threadIdx.x, wid = tid >> 6, lane = tid & 63, r32 = lane & 31, hi = lane >> 5;
  bf16_t* V_lds = (bf16_t*)lds; bf16_t* K_lds = (bf16_t*)(lds + 2 * SHM_V);
  float* ws = (float*)(lds + 2 * SHM_V + 2 * SHM_K) + wid * 64; float* li_l = ws; float* al_l = ws + 32;
  float m_reg = -1e30f, l_reg = 0; f32x16 o[4] = {}; bf16x8 qr[8];
  const bf16_t* Qw = Qb + (long)(wid * QBLK + r32) * LDQ + hi * 8;
#pragma unroll
  for (int d0 = 0; d0 < 8; ++d0) qr[d0] = *reinterpret_cast<const bf16x8*>(Qw + d0 * 16);
  const int sr = tid >> 4, sc = (tid & 15) * 8, vst0 = v_st(sr, sc), vst1 = v_st(32 + sr, sc);
  const int vb0 = (int)(uintptr_t)V_lds + v_rd_base(lane);
  struct { bf16x8 vs0, vs1, ks0, ks1; } sr_[SDEPTH];
#define SLOAD(i, k0) do { sr_[i].vs0 = *reinterpret_cast<const bf16x8*>(&Vh[(long)((k0) + sr) * LDK + sc]); sr_[i].vs1 = *reinterpret_cast<const bf16x8*>(&Vh[(long)((k0) + 32 + sr) * LDK + sc]); \
    sr_[i].ks0 = *reinterpret_cast<const bf16x8*>(&Kh[(long)((k0) + sr) * LDK + sc]); sr_[i].ks1 = *reinterpret_cast<const bf16x8*>(&Kh[(long)((k0) + 32 + sr) * LDK + sc]); } while (0)
#define SWRITE(b, i) do { *(bf16x8*)((char*)V_lds + (b) * SHM_V + vst0) = sr_[i].vs0;          \
    *(bf16x8*)((char*)V_lds + (b) * SHM_V + vst1) = sr_[i].vs1; int kc = sc * 2;               \
    *(bf16x8*)((char*)K_lds + (b) * SHM_K + KSWZ(sr, kc)) = sr_[i].ks0;                       \
    *(bf16x8*)((char*)K_lds + (b) * SHM_K + KSWZ(32 + sr, kc)) = sr_[i].ks1; } while (0)
#define SWAIT() asm volatile("s_waitcnt vmcnt(4)" ::: "memory")
#define RESC(a) do { if (__any((a) < 1.f)) { if (hi == 0) al_l[r32] = (a); asm volatile("s_waitcnt lgkmcnt(0)" ::: "memory"); \
    for (int d = 0; d < 4; ++d) for (int r = 0; r < 16; ++r) o[d][r] *= al_l[crow(r, hi)]; } } while (0)
  f32x16 pA0, pA1, pB0, pB1; float mnA, mnB, alA, alB; bf16x8 pa0, pa1, pa2, pa3; const int NT = seq / KVBLK;
  constexpr int SE = 0, SO = SDEPTH - 1;
  SLOAD(SE, 0); asm volatile("s_waitcnt vmcnt(0)" ::: "memory"); SWRITE(0, SE); __syncthreads();
  qkt(pA0, pA1, K_lds, qr, r32, hi); partialSM(pA0, pA1, m_reg, mnA, alA);
  SLOAD(SO, KVBLK); if (2 < NT) SLOAD(SE, 2 * KVBLK);
  SWAIT(); SWRITE(1, SO); __syncthreads();
  for (int j = 1; j + 1 < NT; j += 2) {
    SBAR(); qkt(pB0, pB1, (bf16_t*)((char*)K_lds + SHM_K), qr, r32, hi);
    finishSM(pA0, pA1, alA, l_reg, pa0, pa1, pa2, pa3); SBAR();
    SLOAD(SO, (j + SDEPTH) * KVBLK); SBAR();
    pv_d0(o, vb0, pa0, pa1, pa2, pa3); partialSM(pB0, pB1, m_reg, mnB, alB);
    __syncthreads(); SWAIT(); SWRITE(0, SE);
    RESC(alB); __syncthreads();
    SBAR(); qkt(pA0, pA1, K_lds, qr, r32, hi);
    finishSM(pB0, pB1, alB, l_reg, pa0, pa1, pa2, pa3); SBAR();
    if (j + 3 < NT) SLOAD(SE, (j + 1 + SDEPTH) * KVBLK); SBAR();
    pv_d0(o, vb0 + (int)SHM_V, pa0, pa1, pa2, pa3); partialSM(pA0, pA1, m_reg, mnA, alA);
    __syncthreads(); SWAIT(); SWRITE(1, SO);
    RESC(alA); __syncthreads();
  }
  SBAR(); qkt(pB0, pB1, (bf16_t*)((char*)K_lds + SHM_K), qr, r32, hi);
  finishSM(pA0, pA1, alA, l_reg, pa0, pa1, pa2, pa3); SBAR();
  pv_d0(o, vb0, pa0, pa1, pa2, pa3); partialSM(pB0, pB1, m_reg, mnB, alB);
  __syncthreads(); RESC(alB);
  finishSM(pB0, pB1, alB, l_reg, pa0, pa1, pa2, pa3); SBAR();
  pv_d0(o, vb0 + (int)SHM_V, pa0, pa1, pa2, pa3);
  if (hi == 0) li_l[r32] = l_reg; asm volatile("s_waitcnt lgkmcnt(0)" ::: "memory");
  float rli[16];
#pragma unroll
  for (int r = 0; r < 16; ++r) rli[r] = __builtin_amdgcn_rcpf(li_l[crow(r, hi)]);
  bf16_t* Ow = Ob + (long)(wid * QBLK) * LDO;
#pragma unroll
  for (int r = 0; r < 16; ++r) { int orow = crow(r, hi);
    for (int d0 = 0; d0 < 4; ++d0) Ow[(long)orow * LDO + d0 * 32 + r32] = (bf16_t)(cvt_pk_bf16(o[d0][r] * rli[r], 0.f) & 0xffffu); }
  __syncthreads();
#undef SLOAD
#undef SWRITE
#undef SWAIT
#undef RESC
}
#undef KSWZ
}
constexpr size_t MiB = 1u << 20;
constexpr size_t al256(size_t x) { return (x + 255) / 256 * 256; }
constexpr size_t WS_CTL = 0, CTL_ZERO_BYTES = 64 * 1024;
constexpr size_t WS_WIN   = 1 * MiB;
constexpr size_t WS_WAU   = WS_WIN  + (size_t)IN_WIDTH * D_MODEL * 2;
constexpr size_t WS_WPU   = WS_WAU  + (size_t)D_MODEL * 1024 * 2;
constexpr size_t WS_WMO   = WS_WPU  + (size_t)D_MODEL * 1024 * 2;
constexpr size_t WS_WCQ   = WS_WMO  + (size_t)D_MODEL * D_MODEL * 2;
constexpr size_t WS_WCKV  = WS_WCQ  + (size_t)MEM_WIDTH * D_MODEL * 2;
constexpr size_t WS_WCO   = WS_WCKV + (size_t)2 * MEM_WIDTH * D_MODEL * 2;
constexpr size_t WS_WPOOL = WS_WCO  + (size_t)D_MODEL * MEM_WIDTH * 2;
constexpr size_t WS_H     = WS_WPOOL + (size_t)4 * 256 * 256 * 2;
constexpr size_t WS_MN    = WS_H    + (size_t)NTOK * D_MODEL * 2;
constexpr size_t WS_PROJ  = WS_MN   + (size_t)MEM_ROWS * D_MODEL * 2;
constexpr size_t WS_KVC   = WS_PROJ + (size_t)NTOK * IN_WIDTH * 2;
constexpr size_t WS_PBUF  = WS_KVC  + (size_t)MEM_ROWS * 1024 * 2;
constexpr size_t WS_POOL  = WS_PBUF + (size_t)NTOK * 1024 * 2;
constexpr size_t WS_ATTN  = WS_POOL + (size_t)NTOK * 1024 * 2;
constexpr size_t WS_SCR   = WS_ATTN + (size_t)NTOK * 1024 * 2;
constexpr size_t WS_MIXED = WS_SCR  + (size_t)NTOK * D_MODEL * 4;
constexpr size_t WS_X1    = WS_MIXED + (size_t)NTOK * D_MODEL * 2;
constexpr size_t WS_X1B   = WS_X1   + (size_t)NTOK * D_MODEL * 4;
constexpr size_t WS_SS1   = WS_X1B  + (size_t)NTOK * D_MODEL * 2;
constexpr size_t WS_QC    = WS_SS1  + (size_t)NTOK * 32 * 4;
constexpr size_t WS_OC    = WS_QC   + (size_t)NTOK * MEM_WIDTH * 2;
constexpr size_t WS_X2    = WS_OC   + (size_t)NTOK * MEM_WIDTH * 2;
constexpr size_t WS_TOKE  = WS_X2   + (size_t)NTOK * D_MODEL * 4;
constexpr size_t WS_TOKP  = WS_TOKE + (size_t)NTOK * 4 * 4;
constexpr size_t WS_TOKG  = WS_TOKP + (size_t)NTOK * 4 * 4;
constexpr size_t WS_LTOK  = WS_TOKG + (size_t)NTOK * 4 * 4;
constexpr size_t WS_LGATE = WS_LTOK + (size_t)N_EXPERTS * ECAP * 4;
constexpr size_t WS_ACT   = WS_LGATE + (size_t)N_EXPERTS * ECAP * 4;
constexpr size_t WS_YS    = WS_ACT  + (size_t)SLOT_ROWS * F8_PITCH;
constexpr size_t WS_WGU   = WS_YS   + (size_t)SLOT_ROWS * D_MODEL * 2;
constexpr size_t WS_WDN   = WS_WGU  + (size_t)N_EXPERTS * 4096 * 2048;
constexpr size_t WS_END   = WS_WDN  + (size_t)N_EXPERTS * 2048 * 2048;
constexpr int CW_BAR = 1024;
constexpr int CW_CNT = 8192;
static_assert((CW_CNT + 32 * 64) * 4 <= (int)CTL_ZERO_BYTES, "CTL words inside the memset region");
constexpr int RING_BYTES = 131072, MISC_OFF = RING_BYTES, TAB_OFF = RING_BYTES + 512;
constexpr int TAB_TSTART = TAB_OFF, TAB_CNT = TAB_OFF + 34 * 4, TAB_TILEE = TAB_CNT + 32 * 4, TAB_RSTD = TAB_TILEE + MAX_TILES * 4, TAB_END = TAB_RSTD + 256 * 4;
constexpr int LDS_BYTES = 147456;
static_assert(TAB_END <= LDS_BYTES, "LDS map");
constexpr int NWAVES = 8;

#define RLX_AGENT __ATOMIC_RELAXED, __HIP_MEMORY_SCOPE_AGENT
#define LDS_WAIT() asm volatile("s_waitcnt lgkmcnt(0)" ::: "memory")
#define XB_TMO      128
#define XB_XCNT(j)  (256  + 64 * (j))
#define XB_XSUB(j)  (1280 + 64 * (j))
#define XB_XGEN(j)  (2304 + 64 * (j))
#define XB_TOP      3328
#define XB_TOPGEN   3392
#define XCD_BAR_WORDS 3456
#define XB_SPIN_CAP (1u << 18)
__device__ __forceinline__ unsigned xb_ld(unsigned* p)              { return __hip_atomic_load(p, __ATOMIC_RELAXED, __HIP_MEMORY_SCOPE_AGENT); }
__device__ __forceinline__ unsigned xb_add(unsigned* p, unsigned v) { return __hip_atomic_fetch_add(p, v, __ATOMIC_RELAXED, __HIP_MEMORY_SCOPE_AGENT); }
__device__ __forceinline__ unsigned xb_xcc_id() { return (unsigned)__builtin_amdgcn_s_getreg((3 << 11) | 20) & 0xFu; }
#define XB_SPIN(cond, bar) do { unsigned _sp = 0; while (cond) { __builtin_amdgcn_s_sleep(1); \
    if ((++_sp & 255u) == 0u) { if (xb_ld(&(bar)[XB_TMO])) break; if (_sp > XB_SPIN_CAP) { atomicAdd(&(bar)[XB_TMO], 1u); break; } } } } while (0)
struct XcdBarrier { unsigned* bar; unsigned x; volatile LAS unsigned* st; };
__device__ __forceinline__ XcdBarrier xcd_barrier_post(unsigned* bar, volatile LAS unsigned* st) {
    XcdBarrier b; b.bar = bar; b.x = xb_xcc_id(); b.st = st;
    if (threadIdx.x == 0) (void)xb_add(&bar[XB_XCNT(b.x)], 1u);
    return b;
}
__device__ __forceinline__ void xcd_barrier_complete(unsigned* bar, unsigned x, unsigned& nloc, unsigned& nx) {
    const unsigned G = gridDim.x * gridDim.y * gridDim.z;
    unsigned sum, cnt, mine, sp = 0u;
    for (;;) {
        sum = 0u; cnt = 0u; mine = 0u;
#pragma unroll
        for (unsigned j = 0; j < 16; ++j) { const unsigned c = xb_ld(&bar[XB_XCNT(j)]); sum += c; cnt += (c > 0u) ? 1u : 0u; mine = (j == x) ? c : mine; }
        if (sum == G) break;
        __builtin_amdgcn_s_sleep(1);
        if ((++sp & 255u) == 0u) { if (xb_ld(&bar[XB_TMO])) break; if (sp > XB_SPIN_CAP) { atomicAdd(&bar[XB_TMO], 1u); break; } }
    }
    nloc = mine > 0u ? mine : 1u; nx = cnt > 0u ? cnt : 1u;
}
__device__ __forceinline__ void xcd_barrier(const XcdBarrier& b) {
    asm volatile("s_waitcnt vmcnt(0)" ::: "memory");
    __syncthreads();
    if (threadIdx.x == 0) {
        unsigned* bar = b.bar;
        __builtin_amdgcn_s_waitcnt(0);
        unsigned nloc = b.st[0], nx = b.st[1];
        if (nloc == 0u) { xcd_barrier_complete(bar, b.x, nloc, nx); b.st[0] = nloc; b.st[1] = nx; }
        const unsigned old = xb_add(&bar[XB_XSUB(b.x)], 1u);
        const unsigned gen = old / nloc;
        if (old + 1u == (gen + 1u) * nloc) {
            __builtin_amdgcn_fence(__ATOMIC_RELEASE, "agent");
            asm volatile("s_waitcnt vmcnt(0)" ::: "memory");
            const unsigned og = xb_add(&bar[XB_TOP], 1u);
            const unsigned tg = og / nx;
            if (og + 1u == (tg + 1u) * nx) xb_add(&bar[XB_TOPGEN], 1u);
            else XB_SPIN(xb_ld(&bar[XB_TOPGEN]) == tg, bar);
            __builtin_amdgcn_fence(__ATOMIC_ACQUIRE, "agent");
            xb_add(&bar[XB_XGEN(b.x)], 1u);
            asm volatile("s_waitcnt vmcnt(0)" ::: "memory");
        } else {
            XB_SPIN(xb_ld(&bar[XB_XGEN(b.x)]) == gen, bar);
            __builtin_amdgcn_fence(__ATOMIC_ACQUIRE, "agent");
            asm volatile("s_waitcnt vmcnt(0)" ::: "memory");
        }
    }
    __syncthreads();
}
__device__ __forceinline__ void xcd_arrive(const XcdBarrier& b) {
    asm volatile("s_waitcnt vmcnt(0)" ::: "memory");
    __syncthreads();
    if (threadIdx.x == 0) {
        unsigned* bar = b.bar;
        __builtin_amdgcn_s_waitcnt(0);
        unsigned nloc = b.st[0], nx = b.st[1];
        if (nloc == 0u) { xcd_barrier_complete(bar, b.x, nloc, nx); b.st[0] = nloc; b.st[1] = nx; }
        const unsigned old = xb_add(&bar[XB_XSUB(b.x)], 1u);
        const unsigned gen = old / nloc;
        if (old + 1u == (gen + 1u) * nloc) {
            __builtin_amdgcn_fence(__ATOMIC_RELEASE, "agent");
            asm volatile("s_waitcnt vmcnt(0)" ::: "memory");
            const unsigned og = xb_add(&bar[XB_TOP], 1u);
            const unsigned tg = og / nx;
            if (og + 1u == (tg + 1u) * nx) xb_add(&bar[XB_TOPGEN], 1u);
            else XB_SPIN(xb_ld(&bar[XB_TOPGEN]) == tg, bar);
            __builtin_amdgcn_fence(__ATOMIC_ACQUIRE, "agent");
            xb_add(&bar[XB_XGEN(b.x)], 1u);
            asm volatile("s_waitcnt vmcnt(0)" ::: "memory");
            b.st[2] = 0u;
        } else { b.st[3] = gen; b.st[2] = 1u; }
    }
    __syncthreads();
}
__device__ __forceinline__ void xcd_wait(const XcdBarrier& b) {
    asm volatile("s_waitcnt vmcnt(0)" ::: "memory");
    __syncthreads();
    if (threadIdx.x == 0) {
        unsigned* bar = b.bar;
        __builtin_amdgcn_s_waitcnt(0);
        if (b.st[2] != 0u) { const unsigned gen = b.st[3]; XB_SPIN(xb_ld(&bar[XB_XGEN(b.x)]) == gen, bar); b.st[2] = 0u; }
        __builtin_amdgcn_fence(__ATOMIC_ACQUIRE, "agent");
        asm volatile("s_waitcnt vmcnt(0)" ::: "memory");
    }
    __syncthreads();
}

__device__ __forceinline__ float wave_sum(float v) {
#pragma unroll
    for (int o = 1; o < 64; o <<= 1) v += __shfl_xor(v, o);
    return v;
}
__device__ __forceinline__ void rms_row_bf16(const float* xrow, const float* g, bf16_t* orow, int lane) {
    const f32x4* xr = (const f32x4*)xrow + lane; const f32x4* gr = (const f32x4*)g + lane;
    f32x4 v[8]; float s = 0.f;
#pragma unroll
    for (int j = 0; j < 8; ++j) { v[j] = xr[64 * j]; s += (v[j][0] * v[j][0] + v[j][1] * v[j][1]) + (v[j][2] * v[j][2] + v[j][3] * v[j][3]); }
    const float rstd = rsqrtf(wave_sum(s) * (1.f / D_MODEL) + NORM_EPS);
    u32x2* o8 = (u32x2*)orow + lane;
#pragma unroll
    for (int j = 0; j < 8; ++j) { const f32x4 w = v[j] * rstd * gr[64 * j]; u32x2 o; o.x = cvt_pk_bf16(w[0], w[1]); o.y = cvt_pk_bf16(w[2], w[3]); o8[64 * j] = o; }
}
__device__ __forceinline__ void cvt_store_lines(LAS unsigned char* buf, const u32x4 (&pc)[4], unsigned char* WTblk  , size_t pitchB, int wave, int lane) {
#pragma unroll
    for (int j = 0; j < 4; ++j) { const int n = 4 * lane + j; *(LAS u32x4*)(buf + n * 128 + (((wave + (n >> 2)) & 7) << 4)) = pc[j]; }
    asm volatile("s_waitcnt lgkmcnt(0)" ::: "memory"); __builtin_amdgcn_s_barrier(); asm volatile("" ::: "memory");
#pragma unroll
    for (int i = 0; i < 4; ++i) { const int row = 32 * wave + 8 * i + (lane >> 3), c = lane & 7; const u32x4 w = *(const LAS u32x4*)(buf + row * 128 + (((c + (row >> 2)) & 7) << 4));
        __builtin_nontemporal_store(w, (u32x4*)(WTblk + (size_t)row * pitchB + 16 * c)); }
}
__device__ __forceinline__ void cvt_blk_bf16(LAS unsigned char* buf, const float* W, int K, int N, bf16_t* WT, const float* kscale, int blk, int wave, int lane) {
    const int nblk = N / 256, kb = blk / nblk, nb = blk % nblk, k0 = 64 * kb + 8 * wave, n0 = 256 * nb + 4 * lane;
    const float* src = W + (size_t)k0 * N + n0; f32x4 v[8];
#pragma unroll
    for (int r = 0; r < 8; ++r) v[r] = __builtin_nontemporal_load((const f32x4*)(src + (size_t)r * N));
    if (kscale) { const f32x4 s0 = *(const f32x4*)(kscale + k0), s1 = *(const f32x4*)(kscale + k0 + 4);
#pragma unroll
        for (int r = 0; r < 4; ++r) { v[r] = v[r] * s0[r]; v[4 + r] = v[4 + r] * s1[r]; } }
    u32x4 pc[4];
#pragma unroll
    for (int j = 0; j < 4; ++j) { pc[j].x = cvt_pk_bf16(v[0][j], v[1][j]); pc[j].y = cvt_pk_bf16(v[2][j], v[3][j]); pc[j].z = cvt_pk_bf16(v[4][j], v[5][j]); pc[j].w = cvt_pk_bf16(v[6][j], v[7][j]); }
    cvt_store_lines(buf, pc, (unsigned char*)(WT + (size_t)(256 * nb) * K + 64 * kb), (size_t)K * 2, wave, lane);
}
__device__ __forceinline__ void cvt_blk_fp8(LAS unsigned char* buf, const float* W, int K, int N, unsigned char* WT, int blk, int wave, int lane) {
    const int nblk = N / 256, kb = blk / nblk, nb = blk % nblk, k0 = 128 * kb + 16 * wave, n0 = 256 * nb + 4 * lane;
    const float* src = W + (size_t)k0 * N + n0; f32x4 v[16];
#pragma unroll
    for (int r = 0; r < 16; ++r) v[r] = __builtin_nontemporal_load((const f32x4*)(src + (size_t)r * N)) * W_FP8_MUL;
    u32x4 pc[4];
#pragma unroll
    for (int j = 0; j < 4; ++j) { pc[j].x = pack4_fp8(v[0][j], v[1][j], v[2][j], v[3][j]); pc[j].y = pack4_fp8(v[4][j], v[5][j], v[6][j], v[7][j]); pc[j].z = pack4_fp8(v[8][j], v[9][j], v[10][j], v[11][j]); pc[j].w = pack4_fp8(v[12][j], v[13][j], v[14][j], v[15][j]); }
    cvt_store_lines(buf, pc, WT + ((size_t)nb * (K / 128) + kb) * 32768, (size_t)128, wave, lane);
}
constexpr int CVT_I_GU = 16 * 16, CVT_I_DN = 16 * 8, CVT_NMOE = N_EXPERTS * (CVT_I_GU + CVT_I_DN);
__device__ __forceinline__ void cvt_moe_block(LAS unsigned char* buf, const float* w_gu, const float* w_dn, unsigned char* Wt_gu, unsigned char* Wt_dn, int it, int wave, int lane) {
    if (it < N_EXPERTS * CVT_I_GU) { const int e = it / CVT_I_GU; cvt_blk_fp8(buf, w_gu + (size_t)e * 2048 * 4096, 2048, 4096, Wt_gu + (size_t)e * 4096 * 2048, it % CVT_I_GU, wave, lane); }
    else { const int r = it - N_EXPERTS * CVT_I_GU, e = r / CVT_I_DN; cvt_blk_fp8(buf, w_dn + (size_t)e * 2048 * 2048, 2048, 2048, Wt_dn + (size_t)e * 2048 * 2048, r % CVT_I_DN, wave, lane); }
}
constexpr int DEF1_W0 = 128, DEF1_N = 68, DEF1_B0 = 0,                              DEF1_CNT = (256 - DEF1_W0) * DEF1_N;
constexpr int DEF6_W0 = 64, DEF6_N = 15, DEF6_B0 = DEF1_B0 + DEF1_CNT,             DEF6_CNT = (256 - DEF6_W0) * DEF6_N;
constexpr int DEF7_W0 = 128, DEF7_N = 0, DEF7_B0 = DEF6_B0 + DEF6_CNT,            DEF7_CNT = (256 - DEF7_W0) * DEF7_N;
constexpr int DEF3_W0 = 128, DEF3_N = 2, DEF3_B0 = DEF7_B0 + DEF7_CNT,            DEF3_CNT = (256 - DEF3_W0) * DEF3_N;
constexpr int DEF1S_W0 = 72, DEF1S_N = 8, DEF1S_B0 = DEF3_B0 + DEF3_CNT, DEF1S_CNT = (DEF1_W0 - DEF1S_W0) * DEF1S_N;
constexpr int DEF_TOTAL = DEF1S_B0 + DEF1S_CNT;
static_assert(DEF_TOTAL <= CVT_NMOE, "deferred MoE blocks");
#define CVT_DEFERRED(W0, N, B0) do { if (G == 256 && bx >= (W0)) { _Pragma("unroll 1") for (int _j = 0; _j < (N); ++_j) \
        cvt_moe_block(lds + (_j & 1) * 32768, args.in[20], args.in[22], Wt_gu, Wt_dn, (B0) + (bx - (W0)) + (256 - (W0)) * _j, wave, lane); __syncthreads(); } } while (0)
__device__ __forceinline__ MoeTab build_moe_tables(LAS unsigned char* lds, unsigned* ctl) {
    LAS int* tstart = (LAS int*)(lds + TAB_TSTART); LAS int* cnt = (LAS int*)(lds + TAB_CNT); LAS int* tile_e = (LAS int*)(lds + TAB_TILEE);
    if (threadIdx.x < 64) {
        const int e = threadIdx.x & 31; const int c = (int)__hip_atomic_load(ctl + CW_CNT + 64 * e, RLX_AGENT); const int nt = (c + 255) >> 8;
        int incl = nt;
#pragma unroll
        for (int o = 1; o < 32; o <<= 1) { const int t = __shfl_up(incl, o, 64); if (e >= o) incl += t; }
        const int excl = incl - nt;
        if (threadIdx.x < 32) { cnt[e] = c; tstart[e] = excl; if (e == 31) tstart[32] = incl; for (int j = 0; j < nt; ++j) tile_e[excl + j] = e; }
    }
    __syncthreads();
    MoeTab T; T.tstart = tstart; T.cnt = cnt; T.tile_e = tile_e; return T;
}

struct Args { const float* in[25]; float* out; unsigned char* ws; int ph_lo, ph_hi, probe, pad; };
static_assert(sizeof(Args) == 27 * 8 + 16, "Args has no padding");
constexpr int N_PHASES = 13;

__global__ void __launch_bounds__(NWAVES * 64, 2) mk_fwd(Args args) {
    extern __shared__ __attribute__((aligned(16))) unsigned char lds_g[];
    LAS unsigned char* lds = (LAS unsigned char*)lds_g;
    volatile LAS unsigned* MISC = (volatile LAS unsigned*)(lds + MISC_OFF);
    const int tid = threadIdx.x, lane = tid & 63, wave = __builtin_amdgcn_readfirstlane(tid >> 6);
    const int G = gridDim.x, bx = blockIdx.x; const int vcu = (G % 8 == 0) ? (bx % 8) * (G / 8) + bx / 8 : bx;
    const int gw = vcu * NWAVES + wave, NGW = G * NWAVES;
    unsigned char* ws = args.ws; unsigned* ctl = (unsigned*)(ws + WS_CTL);
    const int lo = args.ph_lo, hi = args.ph_hi;
    for (int u = tid; u < (LDS_BYTES - MISC_OFF) / 4; u += NWAVES * 64) ((LAS unsigned*)(lds + MISC_OFF))[u] = 0u;
    __syncthreads();
    XcdBarrier bar; bar.bar = ctl + CW_BAR; bar.x = 0; bar.st = nullptr;
    if (hi - lo > 1) bar = xcd_barrier_post(ctl + CW_BAR, MISC + 8);
#define IN(k) (lo <= (k) && (k) < hi)
#define SEAM(k) do { if (IN(k) && IN((k) + 1)) xcd_barrier(bar); } while (0)
#define SEAM_SPLIT(k, indep) do { if (IN(k) && IN((k) + 1)) { if (indep) xcd_arrive(bar); else xcd_barrier(bar); } } while (0)
#define SEAM_JOIN(k, indep) do { if (IN(k) && IN((k) + 1) && (indep)) xcd_wait(bar); } while (0)
    const float* x = args.in[0]; const float* mem = args.in[1];
    bf16_t* Wt_in = (bf16_t*)(ws + WS_WIN); bf16_t* Wt_au = (bf16_t*)(ws + WS_WAU); bf16_t* Wt_pu = (bf16_t*)(ws + WS_WPU); bf16_t* Wt_mo = (bf16_t*)(ws + WS_WMO);
    bf16_t* Wt_cq = (bf16_t*)(ws + WS_WCQ); bf16_t* Wt_ckv = (bf16_t*)(ws + WS_WCKV); bf16_t* Wt_co = (bf16_t*)(ws + WS_WCO); bf16_t* Wt_pool = (bf16_t*)(ws + WS_WPOOL);
    unsigned char* Wt_gu = ws + WS_WGU; unsigned char* Wt_dn = ws + WS_WDN;
    bf16_t* hbuf = (bf16_t*)(ws + WS_H); bf16_t* mnb = (bf16_t*)(ws + WS_MN); bf16_t* proj = (bf16_t*)(ws + WS_PROJ); bf16_t* kvc = (bf16_t*)(ws + WS_KVC);
    bf16_t* pbuf = (bf16_t*)(ws + WS_PBUF); bf16_t* poolb = (bf16_t*)(ws + WS_POOL); bf16_t* attnb = (bf16_t*)(ws + WS_ATTN); bf16_t* scratch = (bf16_t*)(ws + WS_SCR);
    bf16_t* mixed = (bf16_t*)(ws + WS_MIXED); bf16_t* x1b = (bf16_t*)(ws + WS_X1B); float* ss1 = (float*)(ws + WS_SS1);
    bf16_t* qc = (bf16_t*)(ws + WS_QC); bf16_t* oc = (bf16_t*)(ws + WS_OC); bf16_t* x2b = (bf16_t*)(ws + WS_X2);
    int* tok_e = (int*)(ws + WS_TOKE); int* tok_pos = (int*)(ws + WS_TOKP); float* tok_gate = (float*)(ws + WS_TOKG); int* list_tok = (int*)(ws + WS_LTOK); float* list_gate = (float*)(ws + WS_LGATE);
    unsigned char* act = ws + WS_ACT; unsigned char* ys = ws + WS_YS; unsigned char* h3f = ws + WS_H;

    if (IN(0)) {
        constexpr int I_IN = 32 * 26, I_UP = 16 * 8, I_MO = 32 * 8, I_C = 32 * 2, I_CO = 8 * 8, I_PW = 4 * 1, I_GU = 16 * 16, I_DN = 16 * 8;
        constexpr int NDENSE = I_IN + 2 * I_UP + I_MO + 3 * I_C + I_CO + 4 * I_PW, NMOE = N_EXPERTS * (I_GU + I_DN);
        for (int m = gw; m < NTOK; m += NGW) rms_row_bf16(x + (size_t)m * D_MODEL, args.in[2], hbuf + (size_t)m * D_MODEL, lane);
        for (int m = gw; m < MEM_ROWS; m += NGW) rms_row_bf16(mem + (size_t)m * D_MODEL, args.in[12], mnb + (size_t)m * D_MODEL, lane);
        int pp = 0;
        for (int it = vcu; it < NDENSE; it += G, pp ^= 1) { LAS unsigned char* buf = lds + pp * 32768;
            int r = it;
            if (r < I_IN) { cvt_blk_bf16(buf, args.in[3], 2048, IN_WIDTH, Wt_in, nullptr, r, wave, lane); continue; } r -= I_IN;
            if (r < I_UP) { cvt_blk_bf16(buf, args.in[8], 1024, 2048, Wt_au, nullptr, r, wave, lane); continue; } r -= I_UP;
            if (r < I_UP) { cvt_blk_bf16(buf, args.in[9], 1024, 2048, Wt_pu, nullptr, r, wave, lane); continue; } r -= I_UP;
            if (r < I_MO) { cvt_blk_bf16(buf, args.in[10], 2048, 2048, Wt_mo, nullptr, r, wave, lane); continue; } r -= I_MO;
            if (r < I_C)  { cvt_blk_bf16(buf, args.in[13], 2048, 512, Wt_cq, args.in[11], r, wave, lane); continue; } r -= I_C;
            if (r < I_C)  { cvt_blk_bf16(buf, args.in[14], 2048, 512, Wt_ckv, nullptr, r, wave, lane); continue; } r -= I_C;
            if (r < I_C)  { cvt_blk_bf16(buf, args.in[15], 2048, 512, Wt_ckv + (size_t)512 * 2048, nullptr, r, wave, lane); continue; } r -= I_C;
            if (r < I_CO) { cvt_blk_bf16(buf, args.in[16], 512, 2048, Wt_co, nullptr, r, wave, lane); continue; } r -= I_CO;
            { const int g = r / I_PW; cvt_blk_bf16(buf, args.in[6] + (size_t)g * 65536, 256, 256, Wt_pool + (size_t)g * 65536, nullptr, r % I_PW, wave, lane); }
        }
        for (int it = (G == 256 ? DEF_TOTAL : 0) + vcu; it < NMOE; it += G, pp ^= 1) cvt_moe_block(lds + pp * 32768, args.in[20], args.in[22], Wt_gu, Wt_dn, it, wave, lane);
        __syncthreads();
    }
    const bool indep1 = (G == 256 && bx >= DEF1_W0);
    SEAM_SPLIT(0, indep1);
#ifdef MK_PROBE_P1
    if (IN(1) && args.probe == 1) {
        ProjSched S{(const char*)hbuf, (const char*)Wt_in, (const char*)mnb, (const char*)Wt_ckv, G, bx};
        EpiProj E{proj, kvc};
        pg8::gemm_phase<EpiProj, ProjSched, true, true>(lds, 2048, 2048, MK_PROBE_P1, S, E);
    }
#endif
    if (IN(1) && args.probe == 0) {
        const bool split = (G == 256);
        if (!split || bx < DEF1_W0) {
            ProjSched S{(const char*)hbuf, (const char*)Wt_in, (const char*)mnb, (const char*)Wt_ckv, split ? DEF1_W0 : G, bx};
            EpiProj E{proj, kvc};
            pg8::gemm_phase<EpiProj, ProjSched, true, true>(lds, 2048, 2048, 2048, S, E);
        }
        CVT_DEFERRED(DEF1_W0, DEF1_N, DEF1_B0);
        if (split && bx >= DEF1S_W0 && bx < DEF1_W0) {
#pragma unroll 1
            for (int j = 0; j < DEF1S_N; ++j) cvt_moe_block(lds + (j & 1) * 32768, args.in[20], args.in[22], Wt_gu, Wt_dn, DEF1S_B0 + (bx - DEF1S_W0) + (DEF1_W0 - DEF1S_W0) * j, wave, lane);
            __syncthreads(); }
    }
    SEAM_JOIN(0, indep1);
    SEAM(1);
    if (IN(2)) {
        LAS f32x2* cs = (LAS f32x2*)lds;
        for (int e = tid; e < 64 * 32; e += NWAVES * 64) { const int pos = e >> 5, i5 = e & 31; const float inv = exp2f(-(float)(2 * i5) * (13.287712379549449f / 64.f)); float sn, cn; sincosf((float)pos * inv, &sn, &cn); cs[e] = (f32x2){cn, sn}; }
        __syncthreads();
        { const float* qg = args.in[4]; const float* kg = args.in[5]; const int l16 = lane & 15;
          float gq[8], gk[8];
#pragma unroll
          for (int j = 0; j < 8; ++j) { gq[j] = qg[8 * l16 + j]; gk[j] = kg[8 * l16 + j]; }
          const bool first = (lane & 4) == 0, colang = (lane & 8) != 0;
          for (int task = gw; task < NTOK / 4; task += NGW) {
            u32x4 v[4][3];
#pragma unroll
            for (int tk = 0; tk < 4; ++tk)
#pragma unroll
                for (int g = 0; g < 3; ++g) { const int head = 4 * g + (lane >> 4); v[tk][g] = (u32x4){0u, 0u, 0u, 0u}; if (head < 10) v[tk][g] = *(const u32x4*)(proj + (size_t)(task * 4 + tk) * IN_WIDTH + head * 128 + 8 * l16); }
#pragma unroll
            for (int tk = 0; tk < 4; ++tk) { const int tok = task * 4 + tk, t = tok % SEQ, pos = colang ? (t & 63) : (t >> 6);
                const LAS f32x4* cp = (const LAS f32x4*)(cs + pos * 32 + 8 * (lane & 3)); const f32x4 c0 = cp[0], c1 = cp[1], c2 = cp[2], c3 = cp[3];
                const float cv[8] = {c0[0], c0[2], c1[0], c1[2], c2[0], c2[2], c3[0], c3[2]}, sv[8] = {c0[1], c0[3], c1[1], c1[3], c2[1], c2[3], c3[1], c3[3]};
#pragma unroll
                for (int g = 0; g < 3; ++g) { const int head = 4 * g + (lane >> 4); const u32x4 w = v[tk][g];
                    float xv[8] = {bf_lo(w.x), bf_hi(w.x), bf_lo(w.y), bf_hi(w.y), bf_lo(w.z), bf_hi(w.z), bf_lo(w.w), bf_hi(w.w)}; float ss = 0.f;
#pragma unroll
                    for (int j = 0; j < 8; ++j) ss += xv[j] * xv[j];
                    ss += __shfl_xor(ss, 1); ss += __shfl_xor(ss, 2); ss += __shfl_xor(ss, 4); ss += __shfl_xor(ss, 8);
                    const float rs = rsqrtf(ss * (1.f / 128.f) + NORM_EPS); float ov[8];
#pragma unroll
                    for (int j = 0; j < 8; ++j) { xv[j] = xv[j] * rs * (g < 2 ? gq[j] : gk[j]); const float pj = __shfl_xor(xv[j], 4); ov[j] = first ? (xv[j] * cv[j] - pj * sv[j]) : (xv[j] * cv[j] + pj * sv[j]); }
                    u32x4 o; o.x = cvt_pk_bf16(ov[0], ov[1]); o.y = cvt_pk_bf16(ov[2], ov[3]); o.z = cvt_pk_bf16(ov[4], ov[5]); o.w = cvt_pk_bf16(ov[6], ov[7]);
                    if (head < 10) *(u32x4*)(proj + (size_t)tok * IN_WIDTH + head * 128 + 8 * l16) = o; } }
          } }
        for (int task = gw; task < NTOK / 4; task += NGW) {
            const int tg = task >> 1, half = task & 1, tok0 = tg * 8, t0 = tok0 % SEQ, b = tok0 / SEQ, w2 = 1 << (2 * half + (lane >> 5));
            const bf16_t* ubase = proj + (size_t)b * SEQ * IN_WIDTH + V_END + 512 * half + 8 * lane;
            float md[16];
#pragma unroll
            for (int i = 0; i < 16; ++i) md[i] = (i - 8 >= -w2 && i - 8 < w2) ? 1.f : 0.f;
            float acc[8][8]; u32x4 ctr[8];
#pragma unroll
            for (int j = 0; j < 8; ++j)
#pragma unroll
                for (int c = 0; c < 8; ++c) acc[j][c] = 0.f;
            u32x4 rows[23];
#pragma unroll
            for (int r = 0; r < 23; ++r) { const int tt = t0 - 8 + r; rows[r] = (u32x4){0u, 0u, 0u, 0u}; if (tt >= 0 && tt < SEQ) rows[r] = *(const u32x4*)(ubase + (size_t)tt * IN_WIDTH); }
#pragma unroll
            for (int r = 0; r < 23; ++r) { const u32x4 w = rows[r]; const float val[8] = {bf_lo(w.x), bf_hi(w.x), bf_lo(w.y), bf_hi(w.y), bf_lo(w.z), bf_hi(w.z), bf_lo(w.w), bf_hi(w.w)};
                if (r >= 8 && r < 16) ctr[r - 8] = w;
#pragma unroll
                for (int j = 0; j < 8; ++j) { if (r - j >= 0 && r - j < 16) { const float m = md[r - j];
#pragma unroll
                    for (int c = 0; c < 8; ++c) acc[j][c] = fmaf(m, val[c], acc[j][c]); } } }
#pragma unroll
            for (int j = 0; j < 8; ++j) { const int t = t0 + j; int wlo = t - w2; if (wlo < 0) wlo = 0; int whi = t + w2; if (whi > SEQ) whi = SEQ; const float rc = 1.f / (float)(whi - wlo); const u32x4 w = ctr[j];
                u32x4 o; o.x = cvt_pk_bf16(acc[j][0] * rc - bf_lo(w.x), acc[j][1] * rc - bf_hi(w.x)); o.y = cvt_pk_bf16(acc[j][2] * rc - bf_lo(w.y), acc[j][3] * rc - bf_hi(w.y));
                o.z = cvt_pk_bf16(acc[j][4] * rc - bf_lo(w.z), acc[j][5] * rc - bf_hi(w.z)); o.w = cvt_pk_bf16(acc[j][6] * rc - bf_lo(w.w), acc[j][7] * rc - bf_hi(w.w));
                *(u32x4*)(pbuf + (size_t)(tok0 + j) * 1024 + 512 * half + 8 * lane) = o; }
        }
        __syncthreads();
    }
    SEAM(2);
    if (IN(3)) {
        for (int u = bx; u < 256; u += G) { const int combo = (u & 7) >> 1, b = combo >> 1, kvh = combo & 1, idx = ((u >> 3) << 1) | (u & 1), h = kvh * 4 + (idx >> 4), qb = idx & 15;
            const bf16_t* Qb = proj + ((size_t)b * SEQ + qb * 256) * IN_WIDTH + h * 128; const bf16_t* Kh = proj + (size_t)b * SEQ * IN_WIDTH + Q_END + kvh * 128; const bf16_t* Vh = proj + (size_t)b * SEQ * IN_WIDTH + K_END + kvh * 128;
            attn::attn_dense_body<IN_WIDTH, IN_WIDTH, ATTN_WIDTH>(Qb, Kh, Vh, attnb + ((size_t)b * SEQ + qb * 256) * ATTN_WIDTH + h * 128, SEQ, (char*)lds_g); }
        PoolSched S{(const char*)pbuf, (const char*)Wt_pool, G, bx};
        EpiBf16<1> E{poolb, 1024, 256, args.in[7], nullptr};
        pg8::gemm_phase<EpiBf16<1>, PoolSched, false, true>(lds, 1024, 256, 256, S, E);
        CVT_DEFERRED(DEF3_W0, DEF3_N, DEF3_B0);
    }
    SEAM(3);
    if (IN(4)) {
        MixSched S{(const char*)attnb, (const char*)Wt_au, (const char*)poolb, (const char*)Wt_pu, G, bx};
        EpiMix E{proj, scratch, mixed};
        pg8::gemm_phase<EpiMix, MixSched, true, true>(lds, 1024, 1024, 1024, S, E);
    }
    SEAM(4);
    if (IN(5)) {
        DenseSched4 S{(const char*)mixed, (const char*)Wt_mo, 2048, 2048, 32, 8, G, bx};
        EpiResid<false, true> E{x, x1b, ss1};
        pg8::gemm_phase<EpiResid<false, true>, DenseSched4, true, true>(lds, 2048, 2048, 2048, S, E);
    }
    const bool indep6 = (G == 256 && bx >= DEF6_W0);
    SEAM_SPLIT(5, indep6);
    if (IN(6)) {
        if (bx < 64 && G >= 64) {
            int pm, pn; pg8::tile_order<4>(bx, 32, 2, pm, pn); LAS float* rt = (LAS float*)(lds + TAB_RSTD);
            const int row = tid >> 1, hf = tid & 1; const float* sp = ss1 + (size_t)(pm * 256 + row) * 32 + hf * 16; float s = 0.f;
#pragma unroll
            for (int j = 0; j < 4; ++j) { const f32x4 v = *(const f32x4*)(sp + 4 * j); s += (v[0] + v[1]) + (v[2] + v[3]); }
            s += __shfl_xor(s, 1); if (hf == 0) rt[row] = rsqrtf(s * (1.f / D_MODEL) + NORM_EPS);
        }
        __syncthreads();
        DenseSched4 S{(const char*)x1b, (const char*)Wt_cq, 2048, 2048, 32, 2, G, bx};
        EpiBf16<2> E{qc, 512, 256, nullptr, (const LAS float*)(lds + TAB_RSTD)};
        pg8::gemm_phase<EpiBf16<2>, DenseSched4, true, true>(lds, 2048, 2048, 2048, S, E);
        if (bx < 64 && G >= 64) {
            asm volatile("s_waitcnt vmcnt(0)" ::: "memory"); __syncthreads();
            __builtin_amdgcn_fence(__ATOMIC_ACQUIRE, "agent"); asm volatile("s_waitcnt vmcnt(0)" ::: "memory"); __syncthreads();
            int pm, pn; pg8::tile_order<4>(bx, 32, 2, pm, pn); const int b = pm >> 4, qb = pm & 15;
#pragma unroll 1
            for (int hh = 0; hh < 2; ++hh) { const int h = 2 * pn + hh;
                attn::attn_dense_body<MEM_WIDTH, 1024, MEM_WIDTH>(qc + ((size_t)b * SEQ + qb * 256) * MEM_WIDTH + h * 128, kvc + (size_t)b * MEM_LEN * 1024 + h * 128, kvc + (size_t)b * MEM_LEN * 1024 + 512 + h * 128,
                                                               oc + ((size_t)b * SEQ + qb * 256) * MEM_WIDTH + h * 128, MEM_LEN, (char*)lds_g); }
        }
        CVT_DEFERRED(DEF6_W0, DEF6_N, DEF6_B0);
    }
    SEAM_JOIN(5, indep6);
    SEAM(7);
    if (IN(8)) {
        DenseSched S{(const char*)oc, (const char*)Wt_co, 512, 512, 32, 8, G, bx};
        EpiResid<true, false> E{x1b, x2b, nullptr};
        pg8::gemm_phase<EpiResid<true, false>, DenseSched, true, true>(lds, 512, 512, 512, S, E);
    }
    SEAM(8);
    if (IN(9)) {
        const float* gm = args.in[17]; const float* wrt = args.in[18]; const float* brt = args.in[19];
        LAS float* part = (LAS float*)lds;
        LAS float* ssqp = (LAS float*)(lds + 8 * 32 * 33 * 4);
        LAS float* lg = ssqp + 256;
        LAS float* rs_l = lg + 32 * 33;
        LAS int* tsel = (LAS int*)(rs_l + 32);
        LAS float* tgt = (LAS float*)(tsel + 128);
        LAS int* lrank = (LAS int*)(tgt + 128);
        LAS int* hist = lrank + 128;
        LAS int* ebase = hist + 32;
        for (int tt = vcu; tt < NTOK / 32; tt += G) {
            const int tok0 = tt * 32, i = lane & 31, hh = lane >> 5, ks = 256 * wave;
            if (tid < 32) hist[tid] = 0;
            const bf16_t* xr = x2b + (size_t)(tok0 + i) * D_MODEL + ks + 4 * hh; const float* wp = wrt + (size_t)(ks + 4 * hh) * 32 + i; const float* gp = gm + ks + 4 * hh;
            f32x16 acc = {}; float ssq = 0.f;
#pragma unroll 8
            for (int q = 0; q < 32; ++q) { const u32x2 ab = *(const u32x2*)(xr + 8 * q); const f32x4 a = {bf_lo(ab.x), bf_hi(ab.x), bf_lo(ab.y), bf_hi(ab.y)}; const f32x4 gg = *(const f32x4*)(gp + 8 * q);
                const float b0 = wp[(8 * q + 0) * 32], b1 = wp[(8 * q + 1) * 32], b2 = wp[(8 * q + 2) * 32], b3 = wp[(8 * q + 3) * 32];
                ssq += (a[0] * a[0] + a[1] * a[1]) + (a[2] * a[2] + a[3] * a[3]);
                acc = __builtin_amdgcn_mfma_f32_32x32x2f32(a[0], b0 * gg[0], acc, 0, 0, 0); acc = __builtin_amdgcn_mfma_f32_32x32x2f32(a[1], b1 * gg[1], acc, 0, 0, 0);
                acc = __builtin_amdgcn_mfma_f32_32x32x2f32(a[2], b2 * gg[2], acc, 0, 0, 0); acc = __builtin_amdgcn_mfma_f32_32x32x2f32(a[3], b3 * gg[3], acc, 0, 0, 0); }
            ssq += __shfl_xor(ssq, 32);
            if (lane < 32) ssqp[wave * 32 + lane] = ssq;
#pragma unroll
            for (int r = 0; r < 16; ++r) { const int trow = (r & 3) + 8 * (r >> 2) + 4 * hh; part[(wave * 32 + trow) * 33 + i] = acc[r]; }
            __syncthreads();
            { const int tk = tid >> 4, eg = tid & 15; float s2 = 0.f, l0 = 0.f, l1 = 0.f;
#pragma unroll
              for (int w = 0; w < 8; ++w) { s2 += ssqp[w * 32 + tk]; l0 += part[(w * 32 + tk) * 33 + 2 * eg]; l1 += part[(w * 32 + tk) * 33 + 2 * eg + 1]; }
              const float rstd = rsqrtf(s2 * (1.f / D_MODEL) + NORM_EPS);
              lg[tk * 33 + 2 * eg] = l0 * rstd + brt[2 * eg]; lg[tk * 33 + 2 * eg + 1] = l1 * rstd + brt[2 * eg + 1]; if (eg == 0) rs_l[tk] = rstd; }
            __syncthreads();
#define H3_ROW(tk_) { const int _tk = (tk_); const float _rstd = rs_l[_tk]; \
                const u32x2* xr4 = (const u32x2*)(x2b + (size_t)(tok0 + _tk) * D_MODEL) + lane; const f32x4* gr4 = (const f32x4*)gm + lane; unsigned* o4 = (unsigned*)(h3f + (size_t)(tok0 + _tk) * F8_PITCH) + lane; \
                _Pragma("unroll") for (int q = 0; q < 8; ++q) { const u32x2 xb = xr4[64 * q]; const f32x4 w = (f32x4){bf_lo(xb.x), bf_hi(xb.x), bf_lo(xb.y), bf_hi(xb.y)} * _rstd * gr4[64 * q]; o4[64 * q] = pack4_fp8(w[0], w[1], w[2], w[3]); } }
            if (wave != 0) {
#pragma unroll
                for (int j = 0; j < 4; ++j) H3_ROW(wave * 4 + j)
                if (wave <= 4) H3_ROW(wave - 1)
            }
            if (tid < 32) { float v[32];
#pragma unroll
                for (int e = 0; e < 32; ++e) v[e] = lg[tid * 33 + e];
                int sel[4]; float val[4];
#pragma unroll
                for (int k = 0; k < 4; ++k) { int bi = 0; float bv = -INFINITY;
#pragma unroll
                    for (int e = 0; e < 32; ++e) { const bool better = v[e] > bv; bv = better ? v[e] : bv; bi = better ? e : bi; }
                    sel[k] = bi; val[k] = bv;
#pragma unroll
                    for (int e = 0; e < 32; ++e) v[e] = (e == bi) ? -INFINITY : v[e]; }
                float ex[4], den = 0.f;
#pragma unroll
                for (int k = 0; k < 4; ++k) { ex[k] = __expf(val[k] - val[0]); den += ex[k]; }
                const float rden = 1.f / den;
#pragma unroll
                for (int k = 0; k < 4; ++k) { tsel[tid * 4 + k] = sel[k]; tgt[tid * 4 + k] = ex[k] * rden; lrank[tid * 4 + k] = __hip_atomic_fetch_add((int*)(hist + sel[k]), 1, __ATOMIC_RELAXED, __HIP_MEMORY_SCOPE_WORKGROUP); } }
            __syncthreads();
            if (tid < 32) { const int hc = hist[tid]; int bs = 0; if (hc > 0) bs = (int)__hip_atomic_fetch_add(ctl + CW_CNT + 64 * tid, (unsigned)hc, RLX_AGENT); ebase[tid] = bs; }
            __syncthreads();
            if (tid < 128) { const int tk = tid >> 2, k = tid & 3, e = tsel[tk * 4 + k], pos = ebase[e] + lrank[tk * 4 + k]; const float gt = tgt[tk * 4 + k]; const int tg = tok0 + tk;
                tok_e[tg * 4 + k] = e; tok_pos[tg * 4 + k] = pos; tok_gate[tg * 4 + k] = gt; list_tok[(size_t)e * ECAP + pos] = tg; list_gate[(size_t)e * ECAP + pos] = gt; }
            __syncthreads();
        }
    }
    SEAM(9);
#if defined(MK_PROBE_MOE) && (MK_PROBE_MOE & 15) == 9
    if (IN(10) && args.probe == 1) {
        DenseSched S{(const char*)h3f, (const char*)Wt_gu, F8_PITCH / 2, 1024, 32, 72, G, bx};
        EpiSwiglu E{args.in[21], act};
        pg8::gemm_phase<EpiSwiglu, DenseSched, true, true, true>(lds, F8_PITCH / 2, 1024, 1024, S, E);
    }
#elif defined(MK_PROBE_MOE)
    if (IN(10) && args.probe == 1) {
        const MoeTab T = build_moe_tables(lds, ctl);
        Moe1Sched S{(const char*)h3f, (const char*)Wt_gu, list_tok, T, G, bx, (MK_PROBE_MOE >> 4) & 15};
        EpiSwiglu E{args.in[21], act, (MK_PROBE_MOE >> 8)};
        pg8::gemm_phase<EpiSwiglu, Moe1Sched, true, true, ((MK_PROBE_MOE & 15) < 10), ((MK_PROBE_MOE & 15) % 10)>(lds, 1024, 64, ((MK_PROBE_MOE & 15) == 8 || (MK_PROBE_MOE & 15) == 11) ? 2048 : 1024, S, E, 32768);
    }
#endif
    if (IN(10) && args.probe == 0) {
        const MoeTab T = build_moe_tables(lds, ctl);
        Moe1Sched S{(const char*)h3f, (const char*)Wt_gu, list_tok, T, G, bx};
        EpiSwiglu E{args.in[21], act};
        pg8::gemm_phase<EpiSwiglu, Moe1Sched, true, true, true>(lds, 1024, 64, 1024, S, E, 32768);
    }
    SEAM(10);
    if (IN(11)) {
        const MoeTab T = build_moe_tables(lds, ctl);
        Moe2Sched S{(const char*)act, (const char*)Wt_dn, T, G, bx};
        EpiDown E{args.in[23], ys};
        pg8::gemm_phase<EpiDown, Moe2Sched, true, true, true>(lds, 1024, 64, 1024, S, E, 32768);
    }
    SEAM(11);
    if (IN(12)) {
        const MoeTab T = build_moe_tables(lds, ctl);
        const float* gfin = args.in[24];
        auto load_tok = [&](int tok, u32x4 (&xb)[2][2], u32x4 (&yb)[4][2], float (&gt)[4]) {
#pragma unroll
            for (int j = 0; j < 2; ++j) { const u32x4* xr = (const u32x4*)(x2b + (size_t)tok * D_MODEL + 1024 * j + 16 * lane); xb[j][0] = xr[0]; xb[j][1] = xr[1]; }
#pragma unroll
            for (int k = 0; k < 4; ++k) { const int e = tok_e[tok * 4 + k], pos = tok_pos[tok * 4 + k]; gt[k] = tok_gate[tok * 4 + k]; const unsigned char* yr = ys + (size_t)(T.tstart[e] * 256 + pos) * D_MODEL + 16 * lane;
                yb[k][0] = *(const u32x4*)yr; yb[k][1] = *(const u32x4*)(yr + 1024); } };
        auto finish_tok = [&](int tok, const u32x4 (&xb)[2][2], const u32x4 (&yb)[4][2], const float (&gt)[4]) {
            float v[2][16]; float s = 0.f;
#pragma unroll
            for (int j = 0; j < 2; ++j)
#pragma unroll
                for (int h = 0; h < 2; ++h) { const u32x4 w = xb[j][h]; const unsigned ww[4] = {w.x, w.y, w.z, w.w};
#pragma unroll
                    for (int q = 0; q < 4; ++q) { v[j][8 * h + 2 * q] = bf_lo(ww[q]); v[j][8 * h + 2 * q + 1] = bf_hi(ww[q]); } }
#pragma unroll
            for (int k = 0; k < 4; ++k)
#pragma unroll
                for (int j = 0; j < 2; ++j) { const u32x4 w = yb[k][j]; const unsigned ww[4] = {w.x, w.y, w.z, w.w};
#pragma unroll
                    for (int q = 0; q < 4; ++q) { const auto lo = __builtin_amdgcn_cvt_pk_f32_fp8((int)ww[q], false), hi = __builtin_amdgcn_cvt_pk_f32_fp8((int)ww[q], true);
                        v[j][4 * q] += gt[k] * lo[0]; v[j][4 * q + 1] += gt[k] * lo[1]; v[j][4 * q + 2] += gt[k] * hi[0]; v[j][4 * q + 3] += gt[k] * hi[1]; } }
#pragma unroll
            for (int j = 0; j < 2; ++j)
#pragma unroll
                for (int c = 0; c < 16; ++c) s += v[j][c] * v[j][c];
            const float rstd = rsqrtf(wave_sum(s) * (1.f / D_MODEL) + NORM_EPS);
#pragma unroll
            for (int j = 0; j < 2; ++j) { const f32x4* gp = (const f32x4*)(gfin + 1024 * j + 16 * lane); f32x4* op = (f32x4*)(args.out + (size_t)tok * D_MODEL + 1024 * j + 16 * lane);
#pragma unroll
                for (int q = 0; q < 4; ++q) op[q] = (f32x4){v[j][4 * q], v[j][4 * q + 1], v[j][4 * q + 2], v[j][4 * q + 3]} * rstd * gp[q]; } };
        for (int tok = gw; tok < NTOK; tok += 2 * NGW) {
            u32x4 xa[2][2], ya[4][2], xc[2][2], yc[4][2]; float ga[4], gc[4]; const int tok2 = tok + NGW; const bool two = tok2 < NTOK;
            load_tok(tok, xa, ya, ga); if (two) load_tok(tok2, xc, yc, gc);
            finish_tok(tok, xa, ya, ga); if (two) finish_tok(tok2, xc, yc, gc);
        }
    }
#undef IN
#undef SEAM
}

#ifndef MK_N_LAUNCHES
#define MK_N_LAUNCHES 1
#endif
extern "C" void kernel_launch(void* const* d_in, const int* in_sizes, int n_in, void* d_out, int out_size, void* d_ws, size_t ws_size, hipStream_t stream) {
    static int grid = 0;
    if (grid == 0) {
        if (n_in != 25 || out_size != NTOK * D_MODEL || ws_size < WS_END) { fprintf(stderr, "kernel_launch: shape/workspace mismatch (n_in %d out %d ws %zu need %zu)\n", n_in, out_size, ws_size, (size_t)WS_END); grid = -1; return; }
        int dev = 0, cus = 0, per_cu = 0;
        if (hipGetDevice(&dev) != hipSuccess || hipDeviceGetAttribute(&cus, hipDeviceAttributeMultiprocessorCount, dev) != hipSuccess) { grid = -1; return; }
        if (hipFuncSetAttribute((const void*)mk_fwd, hipFuncAttributeMaxDynamicSharedMemorySize, LDS_BYTES) != hipSuccess) { fprintf(stderr, "kernel_launch: hipFuncSetAttribute failed\n"); grid = -1; return; }
        if (hipOccupancyMaxActiveBlocksPerMultiprocessor(&per_cu, (const void*)mk_fwd, NWAVES * 64, LDS_BYTES) != hipSuccess || per_cu < 1) fprintf(stderr, "kernel_launch: occupancy query reports %d\n", per_cu);
        (void)hipGetLastError();
        grid = cus;
    }
    if (grid < 0) return;
    hipMemsetAsync((char*)d_ws + WS_CTL, 0, CTL_ZERO_BYTES, stream);
    Args a; memset(&a, 0, sizeof a);
    for (int i = 0; i < 25; ++i) a.in[i] = (const float*)d_in[i];
    a.out = (float*)d_out; a.ws = (unsigned char*)d_ws;
#ifdef MK_PROBE_P1
    for (int li = 0; li < N_PHASES; ++li) {
        a.ph_lo = li; a.ph_hi = li + 1;
#ifdef MK_PROBE_P1_AT10
        if (li == 10) { a.ph_lo = 1; a.ph_hi = 2; a.probe = 1; hipLaunchKernelGGL(mk_fwd, dim3(grid), dim3(NWAVES * 64), LDS_BYTES, stream, a); a.probe = 0; a.ph_lo = li; a.ph_hi = li + 1; }
#else
        if (li == 1) { a.probe = 1; hipLaunchKernelGGL(mk_fwd, dim3(grid), dim3(NWAVES * 64), LDS_BYTES, stream, a); a.probe = 0; }
#endif
        hipLaunchKernelGGL(mk_fwd, dim3(grid), dim3(NWAVES * 64), LDS_BYTES, stream, a);
    }
#elif defined(MK_PROBE_MOE)
    for (int li = 0; li < N_PHASES; ++li) {
        a.ph_lo = li; a.ph_hi = li + 1;
        if (li == 10) { a.probe = 1; hipLaunchKernelGGL(mk_fwd, dim3(grid), dim3(NWAVES * 64), LDS_BYTES, stream, a); a.probe = 0; }
        hipLaunchKernelGGL(mk_fwd, dim3(grid), dim3(NWAVES * 64), LDS_BYTES, stream, a);
    }
#elif defined(MK_PROBE_DUP)
    for (int li = 0; li < N_PHASES; ++li) {
        a.ph_lo = li; a.ph_hi = li + 1;
        hipLaunchKernelGGL(mk_fwd, dim3(grid), dim3(NWAVES * 64), LDS_BYTES, stream, a);
        if (li == MK_PROBE_DUP) { if (li == 9) hipMemsetAsync((char*)d_ws + WS_CTL + CW_CNT * 4, 0, 32 * 64 * 4, stream); hipLaunchKernelGGL(mk_fwd, dim3(grid), dim3(NWAVES * 64), LDS_BYTES, stream, a); }
    }
#else
    constexpr int NL = MK_N_LAUNCHES;
    for (int li = 0; li < NL; ++li) {
        a.ph_lo = (NL == 1) ? 0 : li; a.ph_hi = (NL == 1) ? N_PHASES : li + 1;
        hipLaunchKernelGGL(mk_fwd, dim3(grid), dim3(NWAVES * 64), LDS_BYTES, stream, a);
    }
#endif
}
```
